# Optimizing an MI355X kernel written in HIP

```python
import jax, jax.numpy as jnp
from jax import lax
import numpy as np

D_MODEL = 1024
BATCH = 8
SEQ = 2048
DEPTH = 1

CHUNK = 64
Q_BLOCK = 128
ROPE_THETA = 10000.0
EPS = 1e-6

A_HEADS = 8
A_KV_HEADS = 2
A_HEAD_DIM = 64
IDX_HEADS = 8
IDX_DIM = 64
TOPK_MAX = 256

B_HEADS = 4
B_HEAD_DIM = 128
CONV_WIDTH = 4

D_FF = 4 * D_MODEL
MIX_WIDTH = A_HEADS * A_HEAD_DIM + B_HEADS * B_HEAD_DIM
B_CONV_CH = 3 * B_HEADS * B_HEAD_DIM

SPLIT_SIZES = (A_HEADS * A_HEAD_DIM, A_KV_HEADS * A_HEAD_DIM, A_KV_HEADS * A_HEAD_DIM,
               IDX_HEADS * IDX_DIM, IDX_DIM, IDX_HEADS,
               B_HEADS * B_HEAD_DIM, B_HEADS * B_HEAD_DIM, B_HEADS * B_HEAD_DIM,
               B_HEADS * B_HEAD_DIM, B_HEADS, B_HEADS)
IN_DIM = sum(SPLIT_SIZES)
SPLIT_POINTS = tuple(int(v) for v in np.cumsum(SPLIT_SIZES)[:-1])

kernel_name = 'hybrid_dsa_gdn_block'


def rms_norm(x, g):
    xf = x.astype(jnp.float32)
    y = xf * lax.rsqrt(jnp.mean(jnp.square(xf), axis=-1, keepdims=True) + EPS)
    return (y * g.astype(jnp.float32)).astype(x.dtype)


def l2_norm(x):
    return x * lax.rsqrt(jnp.sum(jnp.square(x), axis=-1, keepdims=True) + EPS)


def rope(x, pos):
    d = x.shape[-1]
    half = d // 2
    inv_freq = 1.0 / (ROPE_THETA ** (jnp.arange(half, dtype=jnp.float32) / half))
    ang = pos.astype(jnp.float32)[:, None] * inv_freq[None, :]
    cos = jnp.cos(ang)[:, None, :]
    sin = jnp.sin(ang)[:, None, :]
    xf = x.astype(jnp.float32)
    x1, x2 = xf[..., :half], xf[..., half:]
    return jnp.concatenate([x1 * cos - x2 * sin, x2 * cos + x1 * sin], axis=-1).astype(x.dtype)


def causal_depthwise_conv(x, w):
    ch = x.shape[-1]
    return lax.conv_general_dilated(
        x, w[:, None, :].astype(x.dtype), window_strides=(1,),
        padding=[(CONV_WIDTH - 1, 0)], dimension_numbers=('NWC', 'WIO', 'NWC'),
        feature_group_count=ch)


def sparse_indexer_attention(q, k, v, q_idx, k_idx, w_idx):
    bsz, seq = q.shape[0], q.shape[1]
    n_keys = seq
    topk = min(TOPK_MAX, n_keys // 4)
    n_blocks = seq // Q_BLOCK
    group = A_HEADS // A_KV_HEADS
    key_pos = jnp.arange(n_keys)
    gather = jax.vmap(lambda table, idx: table[idx])

    def blocks(a):
        return jnp.moveaxis(a.reshape((bsz, n_blocks, Q_BLOCK) + a.shape[2:]), 1, 0)

    def one_block(args):
        qb, qib, wb, blk = args
        q_pos = blk * Q_BLOCK + jnp.arange(Q_BLOCK)
        limit = (q_pos // CHUNK + 1) * CHUNK
        rel = jax.nn.relu(jnp.einsum('bqhd,bsd->bqhs', qib, k_idx).astype(jnp.float32))
        iscore = jnp.einsum('bqhs,bqh->bqs', rel, wb.astype(jnp.float32))
        iscore = jnp.where(key_pos[None, None, :] < limit[None, :, None], iscore, -jnp.inf)
        _, sel = lax.top_k(iscore, topk)
        valid = sel < limit[None, :, None]
        k_sel = gather(k, sel)
        v_sel = gather(v, sel)
        qg = qb.reshape(bsz, Q_BLOCK, A_KV_HEADS, group, A_HEAD_DIM)
        s = jnp.einsum('bqngd,bqknd->bqngk', qg, k_sel).astype(jnp.float32) * (A_HEAD_DIM ** -0.5)
        s = jnp.where(valid[:, :, None, None, :], s, -jnp.inf)
        p = jax.nn.softmax(s, axis=-1).astype(v.dtype)
        o = jnp.einsum('bqngk,bqknd->bqngd', p, v_sel)
        return o.reshape(bsz, Q_BLOCK, A_HEADS * A_HEAD_DIM)

    out = lax.map(one_block, (blocks(q), blocks(q_idx), blocks(w_idx), jnp.arange(n_blocks)))
    return jnp.moveaxis(out, 0, 1).reshape(bsz, seq, A_HEADS * A_HEAD_DIM)


def gated_delta_rule_chunked(q, k, v, g, beta):
    bsz, seq, nh, dk = q.shape
    dv = v.shape[-1]
    n = seq // CHUNK

    def to_chunks(a):
        return a.reshape(bsz, n, CHUNK, nh, -1).transpose(0, 3, 1, 2, 4)

    q = to_chunks(q) * (dk ** -0.5)
    k = to_chunks(k)
    v = to_chunks(v)
    g = g.reshape(bsz, n, CHUNK, nh).transpose(0, 3, 1, 2)
    beta = beta.reshape(bsz, n, CHUNK, nh).transpose(0, 3, 1, 2)
    gc = jnp.cumsum(g, axis=-1)
    incl = jnp.tril(jnp.ones((CHUNK, CHUNK), dtype=bool))
    strict = jnp.tril(jnp.ones((CHUNK, CHUNK), dtype=bool), k=-1)
    decay = jnp.exp(jnp.where(incl, gc[..., :, None] - gc[..., None, :], -jnp.inf))
    kb = k * beta[..., None]
    m = jnp.where(strict, jnp.einsum('bhncd,bhnsd->bhncs', kb, k) * decay, 0.0)
    a = m + jnp.eye(CHUNK, dtype=m.dtype)
    rhs = jnp.concatenate([v * beta[..., None], kb * jnp.exp(gc)[..., None]], axis=-1)
    sol = lax.linalg.triangular_solve(a, rhs, left_side=True, lower=True, unit_diagonal=True)
    u, w = sol[..., :dv], sol[..., dv:]
    att = jnp.einsum('bhncd,bhnsd->bhncs', q, k) * decay
    q_dec = q * jnp.exp(gc)[..., None]
    k_tail = k * jnp.exp(gc[..., -1:] - gc)[..., None]
    g_last = jnp.exp(gc[..., -1])

    def step(state, inp):
        u_n, w_n, qd_n, att_n, kt_n, gl_n = inp
        v_new = u_n - jnp.einsum('bhcd,bhde->bhce', w_n, state)
        o_n = jnp.einsum('bhcd,bhde->bhce', qd_n, state) + jnp.einsum('bhcs,bhse->bhce', att_n, v_new)
        state = state * gl_n[..., None, None] + jnp.einsum('bhcd,bhce->bhde', kt_n, v_new)
        return state, o_n

    xs = (jnp.moveaxis(u, 2, 0), jnp.moveaxis(w, 2, 0), jnp.moveaxis(q_dec, 2, 0),
          jnp.moveaxis(att, 2, 0), jnp.moveaxis(k_tail, 2, 0), jnp.moveaxis(g_last, 2, 0))
    s0 = jnp.zeros((bsz, nh, dk, dv), jnp.float32)
    _, o = lax.scan(step, s0, xs)
    return o.transpose(1, 0, 3, 2, 4).reshape(bsz, seq, nh, dv)


def gated_deltanet(q, k, v, z, b, a, conv_w, a_log, dt_bias, norm_g):
    bsz, seq = q.shape[0], q.shape[1]
    qkv = jax.nn.silu(causal_depthwise_conv(jnp.concatenate([q, k, v], axis=-1), conv_w))
    qkv = qkv.astype(jnp.float32)
    q, k, v = jnp.split(qkv, 3, axis=-1)
    q = l2_norm(q.reshape(bsz, seq, B_HEADS, B_HEAD_DIM))
    k = l2_norm(k.reshape(bsz, seq, B_HEADS, B_HEAD_DIM))
    v = v.reshape(bsz, seq, B_HEADS, B_HEAD_DIM)
    beta = jax.nn.sigmoid(b.astype(jnp.float32))
    g = -jnp.exp(a_log.astype(jnp.float32)) * jax.nn.softplus(a.astype(jnp.float32) + dt_bias.astype(jnp.float32))
    o = gated_delta_rule_chunked(q, k, v, g, beta)
    zf = z.reshape(bsz, seq, B_HEADS, B_HEAD_DIM).astype(jnp.float32)
    o = rms_norm(o, norm_g) * jax.nn.silu(zf)
    return o.reshape(bsz, seq, B_HEADS * B_HEAD_DIM).astype(z.dtype)


def setup_inputs(seed: int = 0) -> dict:
    key = jax.random.key(seed)
    ks = jax.random.split(key, 13)
    f32 = jnp.float32
    x = jax.random.normal(ks[0], (BATCH, SEQ, D_MODEL), f32)
    norm_mix_g = 1.0 + 0.02 * jax.random.normal(ks[1], (DEPTH, D_MODEL), f32)
    w_in = jax.random.normal(ks[2], (DEPTH, D_MODEL, IN_DIM), f32) * (D_MODEL ** -0.5)
    conv_w = jax.random.normal(ks[3], (DEPTH, CONV_WIDTH, B_CONV_CH), f32) * (CONV_WIDTH ** -0.5)
    a_log = jnp.log(jax.random.uniform(ks[4], (DEPTH, B_HEADS), f32, minval=1.0, maxval=16.0))
    dt = jnp.exp(jax.random.uniform(ks[5], (DEPTH, B_HEADS), f32, minval=np.log(1e-3), maxval=np.log(1e-1)))
    dt_bias = dt + jnp.log(-jnp.expm1(-dt))
    gdn_norm_g = 1.0 + 0.02 * jax.random.normal(ks[6], (DEPTH, B_HEAD_DIM), f32)
    w_out = jax.random.normal(ks[7], (DEPTH, MIX_WIDTH, D_MODEL), f32) * (MIX_WIDTH ** -0.5)
    norm_ffn_g = 1.0 + 0.02 * jax.random.normal(ks[8], (DEPTH, D_MODEL), f32)
    w_ff1 = jax.random.normal(ks[9], (DEPTH, D_MODEL, D_FF), f32) * (D_MODEL ** -0.5)
    w_ff2 = jax.random.normal(ks[10], (DEPTH, D_FF, D_MODEL), f32) * (D_FF ** -0.5)
    norm_final_g = 1.0 + 0.02 * jax.random.normal(ks[11], (D_MODEL,), f32)
    return {'x': x, 'norm_mix_g': norm_mix_g, 'w_in': w_in, 'conv_w': conv_w,
            'a_log': a_log, 'dt_bias': dt_bias, 'gdn_norm_g': gdn_norm_g, 'w_out': w_out,
            'norm_ffn_g': norm_ffn_g, 'w_ff1': w_ff1, 'w_ff2': w_ff2, 'norm_final_g': norm_final_g}


def reference(x, norm_mix_g, w_in, conv_w, a_log, dt_bias, gdn_norm_g, w_out,
              norm_ffn_g, w_ff1, w_ff2, norm_final_g):
    bsz, seq = x.shape[0], x.shape[1]
    pos = jnp.arange(seq)
    for l in range(DEPTH):
        h = rms_norm(x, norm_mix_g[l])
        proj = h @ w_in[l]
        (qa, ka, va, qi, ki, wi, qb, kb, vb, zb, bb, ab) = jnp.split(proj, SPLIT_POINTS, axis=-1)
        qa = rope(qa.reshape(bsz, seq, A_HEADS, A_HEAD_DIM), pos)
        ka = rope(ka.reshape(bsz, seq, A_KV_HEADS, A_HEAD_DIM), pos)
        va = va.reshape(bsz, seq, A_KV_HEADS, A_HEAD_DIM)
        qi = rope(qi.reshape(bsz, seq, IDX_HEADS, IDX_DIM), pos)
        ki = rope(ki.reshape(bsz, seq, 1, IDX_DIM), pos)[:, :, 0]
        wi = wi * ((IDX_HEADS ** -0.5) * (IDX_DIM ** -0.5))
        o_a = sparse_indexer_attention(qa, ka, va, qi, ki, wi)
        o_b = gated_deltanet(qb, kb, vb, zb, bb, ab, conv_w[l], a_log[l], dt_bias[l], gdn_norm_g[l])
        x = x + jnp.concatenate([o_a, o_b], axis=-1) @ w_out[l]
        h = rms_norm(x, norm_ffn_g[l])
        x = x + jnp.square(jax.nn.relu(h @ w_ff1[l])) @ w_ff2[l]
    return rms_norm(x, norm_final_g)
```

```cpp
#include <hip/hip_runtime.h>
#include <cstdio>
#include <math.h>
#include <stdint.h>
#ifdef HOST_TEST
#define HD
#else
#define HD __host__ __device__
#endif

#ifndef CFG_BATCH
#define CFG_BATCH 8
#endif
#ifndef CFG_T
#define CFG_T 2048
#endif
namespace nv {
constexpr int NB = CFG_BATCH, T = CFG_T, D = 1024, FF = 4096;
constexpr int CH = 64, NCH = T / CH;
constexpr int AH = 8, AKV = 2, AD = 64, IH = 8, ID = 64;
constexpr int TOPK = (256 < T / 4) ? 256 : T / 4;
constexpr int BH = 4, BD = 128, CW = 4;
constexpr int IN_DIM = 3408;
constexpr int C_QA = 0, C_KA = 512, C_VA = 640, C_QI = 768, C_KI = 1280, C_WI = 1344, C_QB = 1352, C_KB = 1864, C_VB = 2376, C_ZB = 2888, C_BB = 3400, C_AB = 3404;
constexpr float EPS = 1e-6f;

struct NP {
  const float *x, *g1, *w_in, *conv_w, *a_log, *dt_bias, *gdn_g, *w_out, *g2, *w1, *w2, *gf;
  float* out;
  float *rs;
  float *xn;
  float *proj;
  float *isc;
  unsigned char* sel;
  float *sc;
  float *ml;
  float *qkvc;
  float *bg;
  float *amat;
  float *sol;
  float *att;
  float *S;
  float *vnew;
  float *ob;
  float *mix;
  float *x1;
  float *hid;
  float *x2;
};

HD inline void sincos_acc(float ang, float* s, float* c) {
  double a = (double)ang;
  double kq = rint(a * 0.63661977236758134308);
  double r = a - kq * 1.57079632679489661923;
  double r2 = r * r;
  double sn = r * (1.0 + r2 * (-1.0 / 6 + r2 * (1.0 / 120 + r2 * (-1.0 / 5040 + r2 * (1.0 / 362880 + r2 * (-1.0 / 39916800 + r2 * (1.0 / 6227020800.0)))))));
  double cs = 1.0 + r2 * (-0.5 + r2 * (1.0 / 24 + r2 * (-1.0 / 720 + r2 * (1.0 / 40320 + r2 * (-1.0 / 3628800 + r2 * (1.0 / 479001600.0 + r2 * (-1.0 / 87178291200.0)))))));
  int q = ((int)kq) & 3;
  double ss = (q == 0) ? sn : (q == 1) ? cs : (q == 2) ? -sn : -cs;
  double cc = (q == 0) ? cs : (q == 1) ? -sn : (q == 2) ? -cs : sn;
  *s = (float)ss; *c = (float)cc;
}
HD inline float inv_freq_f(int i) { return 1.0f / powf(10000.0f, (float)i / 32.0f); }
HD inline float silu_f(float v) { return v / (1.0f + expf(-v)); }
HD inline float softplus_f(float v) { return fmaxf(v, 0.f) + log1pf(expf(-fabsf(v))); }

enum Phase {
  PH_RS1 = 0, PH_XN1, PH_PROJ, PH_ROPE, PH_ISC, PH_SEL, PH_SC  , PH_ML, PH_OA,
  PH_CONV, PH_L2, PH_BG, PH_GC, PH_AMAT, PH_SOL, PH_ATT, PH_SCAN_INIT, PH_SCAN  ,
  PH_OBN, PH_MIXB, PH_X1, PH_RS2, PH_XN2, PH_HID, PH_X2, PH_RS3, PH_OUT, PH_COUNT
};

HD inline void phase_run(const NP& p, int ph, int b, int hh, long tid, long nth) {
  const float* xb = p.x + (size_t)b * T * D;
  switch (ph) {
    case PH_RS1: case PH_RS2: case PH_RS3: {
      const float* src = (ph == PH_RS1) ? xb : (ph == PH_RS2) ? p.x1 : p.x2;
      for (long t = tid; t < T; t += nth) { float s = 0.f; for (int k = 0; k < D; ++k) { float v = src[t * D + k]; s = fmaf(v, v, s); } p.rs[t] = 1.0f / sqrtf(s / D + EPS); }
    } break;
    case PH_XN1: case PH_XN2: {
      const float* src = (ph == PH_XN1) ? xb : p.x1; const float* g = (ph == PH_XN1) ? p.g1 : p.g2;
      for (long i = tid; i < (long)T * D; i += nth) { int t = i / D, k = i % D; p.xn[i] = src[i] * p.rs[t] * g[k]; }
    } break;
    case PH_PROJ:
      for (long i = tid; i < (long)T * IN_DIM; i += nth) { int t = i / IN_DIM, n = i % IN_DIM; float a = 0.f; for (int k = 0; k < D; ++k) a = fmaf(p.xn[t * D + k], p.w_in[(size_t)k * IN_DIM + n], a); p.proj[i] = a; }
      break;
    case PH_ROPE: {
      for (long i = tid; i < (long)T * 19 * 32; i += nth) {
        int t = i / (19 * 32), r = i % (19 * 32), hd = r / 32, j = r % 32;
        int col = (hd < 8) ? C_QA + hd * 64 : (hd < 10) ? C_KA + (hd - 8) * 64 : (hd < 18) ? C_QI + (hd - 10) * 64 : C_KI;
        float ang = (float)t * inv_freq_f(j); float sn, cs; sincos_acc(ang, &sn, &cs);
        float* pp = p.proj + (size_t)t * IN_DIM + col; float x1 = pp[j], x2 = pp[j + 32];
        pp[j] = x1 * cs - x2 * sn; pp[j + 32] = x2 * cs + x1 * sn;
      }
    } break;
    case PH_ISC: {
      const float wscale = 0.35355339059327373f * 0.125f;
      for (long i = tid; i < (long)T * T; i += nth) {
        int t = i / T, s = i % T; int limit = (t / CH + 1) * CH;
        if (s >= limit) { p.isc[i] = -INFINITY; continue; }
        const float* q = p.proj + (size_t)t * IN_DIM + C_QI; const float* k = p.proj + (size_t)s * IN_DIM + C_KI; const float* w = p.proj + (size_t)t * IN_DIM + C_WI;
        float acc = 0.f;
        for (int h = 0; h < IH; ++h) { float d = 0.f; for (int e = 0; e < ID; ++e) d = fmaf(q[h * ID + e], k[e], d); acc += fmaxf(d, 0.f) * (w[h] * wscale); }
        p.isc[i] = acc;
      }
    } break;
    case PH_SEL:
      for (long i = tid; i < (long)T * T; i += nth) {
        int t = i / T, s = i % T; int limit = (t / CH + 1) * CH;
        if (s >= limit) { p.sel[i] = 0; continue; }
        const float* row = p.isc + (size_t)t * T; float v = row[s]; int rank = 0;
        for (int s2 = 0; s2 < limit; ++s2) { float u = row[s2]; rank += (u > v || (u == v && s2 < s)) ? 1 : 0; }
        p.sel[i] = rank < TOPK ? 1 : 0;
      }
      break;
    case PH_SC: {
      int n = hh / (AH / AKV);
      for (long i = tid; i < (long)T * T; i += nth) {
        int t = i / T, s = i % T;
        if (!p.sel[i]) { p.sc[i] = -INFINITY; continue; }
        const float* q = p.proj + (size_t)t * IN_DIM + C_QA + hh * AD; const float* k = p.proj + (size_t)s * IN_DIM + C_KA + n * AD;
        float d = 0.f; for (int e = 0; e < AD; ++e) d = fmaf(q[e], k[e], d);
        p.sc[i] = d * 0.125f;
      }
    } break;
    case PH_ML:
      for (long t = tid; t < T; t += nth) {
        int limit = (t / CH + 1) * CH; const float* row = p.sc + (size_t)t * T; float m = -INFINITY;
        for (int s = 0; s < limit; ++s) m = fmaxf(m, row[s]);
        float l = 0.f; for (int s = 0; s < limit; ++s) l += expf(row[s] - m);
        p.ml[2 * t] = m; p.ml[2 * t + 1] = l;
      }
      break;
    case PH_OA: {
      int n = hh / (AH / AKV);
      for (long i = tid; i < (long)T * AD; i += nth) {
        int t = i / AD, e = i % AD; int limit = (t / CH + 1) * CH; const float* row = p.sc + (size_t)t * T; float m = p.ml[2 * t], l = p.ml[2 * t + 1];
        float acc = 0.f;
        for (int s = 0; s < limit; ++s) { float pr = expf(row[s] - m); acc = fmaf(pr, p.proj[(size_t)s * IN_DIM + C_VA + n * AD + e], acc); }
        p.mix[(size_t)t * D + hh * AD + e] = acc / l;
      }
    } break;
    case PH_CONV:
      for (long i = tid; i < (long)T * 1536; i += nth) {
        int t = i / 1536, c = i % 1536; float a = 0.f;
        for (int j = 0; j < CW; ++j) { int tt = t - (CW - 1) + j; if (tt >= 0) a = fmaf(p.conv_w[j * 1536 + c], p.proj[(size_t)tt * IN_DIM + C_QB + c], a); }
        p.qkvc[i] = silu_f(a);
      }
      break;
    case PH_L2:
      for (long i = tid; i < (long)T * 2 * BH; i += nth) {
        int t = i / (2 * BH), r = i % (2 * BH); float* v = p.qkvc + (size_t)t * 1536 + r * BD; float s = 0.f;
        for (int e = 0; e < BD; ++e) s = fmaf(v[e], v[e], s);
        float sc = 1.0f / sqrtf(s + EPS); for (int e = 0; e < BD; ++e) v[e] *= sc;
      }
      break;
    case PH_BG:
      for (long i = tid; i < (long)T * BH; i += nth) {
        int t = i / BH, h = i % BH; float bb = p.proj[(size_t)t * IN_DIM + C_BB + h], ab = p.proj[(size_t)t * IN_DIM + C_AB + h];
        p.bg[i * 3 + 0] = 1.0f / (1.0f + expf(-bb));
        p.bg[i * 3 + 1] = -expf(p.a_log[h]) * softplus_f(ab + p.dt_bias[h]);
      }
      break;
    case PH_GC:
      for (long i = tid; i < (long)NCH * BH; i += nth) {
        int c = i / BH, h = i % BH; float a = 0.f;
        for (int j = 0; j < CH; ++j) { int t = c * CH + j; a += p.bg[((size_t)t * BH + h) * 3 + 1]; p.bg[((size_t)t * BH + h) * 3 + 2] = a; }
      }
      break;
    case PH_AMAT: case PH_ATT:
      for (long i = tid; i < (long)NCH * BH * CH * CH; i += nth) {
        int j = i % CH, ii = (i / CH) % CH, h = (i / (CH * CH)) % BH, c = i / (CH * CH * BH);
        int ti = c * CH + ii, tj = c * CH + j;
        const float* kj = p.qkvc + (size_t)tj * 1536 + 512 + h * BD;
        float gi = p.bg[((size_t)ti * BH + h) * 3 + 2], gj = p.bg[((size_t)tj * BH + h) * 3 + 2];
        float val = 0.f;
        if (ph == PH_AMAT) {
          if (j < ii) { const float* ki = p.qkvc + (size_t)ti * 1536 + 512 + h * BD; float d = 0.f; for (int e = 0; e < BD; ++e) d = fmaf(ki[e], kj[e], d);
            val = d * p.bg[((size_t)ti * BH + h) * 3 + 0] * expf(gi - gj); }
          p.amat[i] = val;
        } else {
          if (j <= ii) { const float* qi = p.qkvc + (size_t)ti * 1536 + h * BD; float d = 0.f; for (int e = 0; e < BD; ++e) d = fmaf(qi[e], kj[e], d);
            val = d * 0.08838834764831845f * expf(gi - gj); }
          p.att[i] = val;
        }
      }
      break;
    case PH_SOL:
      for (long i = tid; i < (long)NCH * BH * 256; i += nth) {
        int col = i % 256, h = (i / 256) % BH, c = i / (256 * BH);
        float* so = p.sol + ((size_t)(c * BH + h) * CH) * 256 + col; const float* am = p.amat + (size_t)(c * BH + h) * CH * CH;
        for (int ii = 0; ii < CH; ++ii) {
          int t = c * CH + ii; float beta = p.bg[((size_t)t * BH + h) * 3 + 0], gcv = p.bg[((size_t)t * BH + h) * 3 + 2];
          float rhs = (col < 128) ? p.qkvc[(size_t)t * 1536 + 1024 + h * BD + col] * beta : p.qkvc[(size_t)t * 1536 + 512 + h * BD + (col - 128)] * beta * expf(gcv);
          float a = rhs; for (int j = 0; j < ii; ++j) a = fmaf(-am[ii * CH + j], so[(size_t)j * 256], a);
          so[(size_t)ii * 256] = a;
        }
      }
      break;
    case PH_SCAN_INIT:
      for (long i = tid; i < (long)BH * 128 * 128; i += nth) p.S[i] = 0.f;
      break;
    case PH_SCAN:
      for (long i = tid; i < (long)BH * 128; i += nth) {
        int h = i / 128, e = i % 128; float* Sc = p.S + (size_t)h * 128 * 128 + e; float* vn = p.vnew + (size_t)h * 64 * 128 + e;
        for (int c = 0; c < NCH; ++c) {
          const float* so = p.sol + ((size_t)(c * BH + h) * CH) * 256; const float* at = p.att + (size_t)(c * BH + h) * CH * CH;
          float gcl = p.bg[((size_t)(c * CH + CH - 1) * BH + h) * 3 + 2];
          for (int ii = 0; ii < CH; ++ii) { float a = so[(size_t)ii * 256 + e]; for (int d = 0; d < 128; ++d) a = fmaf(-so[(size_t)ii * 256 + 128 + d], Sc[(size_t)d * 128], a); vn[(size_t)ii * 128] = a; }
          for (int ii = 0; ii < CH; ++ii) {
            int t = c * CH + ii; float gcv = p.bg[((size_t)t * BH + h) * 3 + 2]; float eg = expf(gcv) * 0.08838834764831845f;
            const float* q = p.qkvc + (size_t)t * 1536 + h * BD; float a = 0.f;
            for (int d = 0; d < 128; ++d) a = fmaf(q[d] * eg, Sc[(size_t)d * 128], a);
            for (int j = 0; j <= ii; ++j) a = fmaf(at[ii * CH + j], vn[(size_t)j * 128], a);
            p.ob[(size_t)t * 512 + h * BD + e] = a;
          }
          float gl = expf(gcl);
          for (int d = 0; d < 128; ++d) {
            float a = Sc[(size_t)d * 128] * gl;
            for (int ii = 0; ii < CH; ++ii) { int t = c * CH + ii; float gcv = p.bg[((size_t)t * BH + h) * 3 + 2]; a = fmaf(p.qkvc[(size_t)t * 1536 + 512 + h * BD + d] * expf(gcl - gcv), vn[(size_t)ii * 128], a); }
            Sc[(size_t)d * 128] = a;
          }
        }
      }
      break;
    case PH_OBN:
      for (long i = tid; i < (long)T * BH; i += nth) {
        int t = i / BH, h = i % BH; float* o = p.ob + (size_t)t * 512 + h * BD; float s = 0.f;
        for (int e = 0; e < BD; ++e) s = fmaf(o[e], o[e], s);
        float r = 1.0f / sqrtf(s / BD + EPS);
        for (int e = 0; e < BD; ++e) { float z = p.proj[(size_t)t * IN_DIM + C_ZB + h * BD + e]; o[e] = o[e] * r * p.gdn_g[e] * silu_f(z); }
      }
      break;
    case PH_MIXB:
      for (long i = tid; i < (long)T * 512; i += nth) { int t = i / 512, c = i % 512; p.mix[(size_t)t * D + 512 + c] = p.ob[i]; }
      break;
    case PH_X1:
      for (long i = tid; i < (long)T * D; i += nth) { int t = i / D, n = i % D; float a = 0.f; for (int k = 0; k < D; ++k) a = fmaf(p.mix[(size_t)t * D + k], p.w_out[(size_t)k * D + n], a); p.x1[i] = xb[i] + a; }
      break;
    case PH_HID:
      for (long i = tid; i < (long)T * FF; i += nth) { int t = i / FF, n = i % FF; float a = 0.f; for (int k = 0; k < D; ++k) a = fmaf(p.xn[(size_t)t * D + k], p.w1[(size_t)k * FF + n], a); a = fmaxf(a, 0.f); p.hid[i] = a * a; }
      break;
    case PH_X2:
      for (long i = tid; i < (long)T * D; i += nth) { int t = i / D, n = i % D; float a = 0.f; for (int k = 0; k < FF; ++k) a = fmaf(p.hid[(size_t)t * FF + k], p.w2[(size_t)k * D + n], a); p.x2[i] = p.x1[i] + a; }
      break;
    case PH_OUT:
      for (long i = tid; i < (long)T * D; i += nth) { int t = i / D, k = i % D; p.out[(size_t)b * T * D + i] = p.x2[i] * p.rs[t] * p.gf[k]; }
      break;
    default: break;
  }
}

HD inline int program(int* ph, int* hh) {
  int n = 0;
  auto add = [&](int a, int b) { ph[n] = a; hh[n] = b; ++n; };
  add(PH_RS1, 0); add(PH_XN1, 0); add(PH_PROJ, 0); add(PH_ROPE, 0); add(PH_ISC, 0); add(PH_SEL, 0);
  for (int h = 0; h < AH; ++h) { add(PH_SC, h); add(PH_ML, h); add(PH_OA, h); }
  add(PH_CONV, 0); add(PH_L2, 0); add(PH_BG, 0); add(PH_GC, 0); add(PH_AMAT, 0); add(PH_SOL, 0); add(PH_ATT, 0); add(PH_SCAN_INIT, 0); add(PH_SCAN, 0);
  add(PH_OBN, 0); add(PH_MIXB, 0); add(PH_X1, 0); add(PH_RS2, 0); add(PH_XN2, 0); add(PH_HID, 0); add(PH_X2, 0); add(PH_RS3, 0); add(PH_OUT, 0);
  return n;
}

inline size_t carve(NP& p, unsigned char* ws) {
  size_t off = 0;
  auto take = [&](size_t bytes) { void* r = ws + off; off += (bytes + 255) & ~(size_t)255; return r; };
  p.rs = (float*)take((size_t)T * 4); p.xn = (float*)take((size_t)T * D * 4); p.proj = (float*)take((size_t)T * IN_DIM * 4);
  p.isc = (float*)take((size_t)T * T * 4); p.sel = (unsigned char*)take((size_t)T * T); p.sc = (float*)take((size_t)T * T * 4); p.ml = (float*)take((size_t)T * 8);
  p.qkvc = (float*)take((size_t)T * 1536 * 4); p.bg = (float*)take((size_t)T * BH * 12); p.amat = (float*)take((size_t)NCH * BH * 64 * 64 * 4);
  p.sol = (float*)take((size_t)NCH * BH * 64 * 256 * 4); p.att = (float*)take((size_t)NCH * BH * 64 * 64 * 4); p.S = (float*)take((size_t)BH * 128 * 128 * 4);
  p.vnew = (float*)take((size_t)BH * 64 * 128 * 4); p.ob = (float*)take((size_t)T * 512 * 4); p.mix = (float*)take((size_t)T * D * 4); p.x1 = (float*)take((size_t)T * D * 4);
  p.hid = (float*)take((size_t)T * FF * 4); p.x2 = (float*)take((size_t)T * D * 4);
  return off;
}
}

#ifndef NAIVE_SINGLE_LAUNCH
#define NAIVE_SINGLE_LAUNCH 0
#endif
#include <hip/hip_cooperative_groups.h>
namespace cg = cooperative_groups;

__global__ void __launch_bounds__(256) k_phase(nv::NP p, int ph, int b, int hh) {
  nv::phase_run(p, ph, b, hh, (long)blockIdx.x * blockDim.x + threadIdx.x, (long)gridDim.x * blockDim.x);
}
__global__ void __launch_bounds__(256) k_all(nv::NP p) {
  cg::grid_group grid = cg::this_grid();
  int ph[64], hh[64];
  const long tid = (long)blockIdx.x * blockDim.x + threadIdx.x, nth = (long)gridDim.x * blockDim.x;
  for (int b = 0; b < nv::NB; ++b) {
#define RUN(a, h) do { nv::phase_run(p, a, b, h, tid, nth); grid.sync(); } while (0)
    RUN(nv::PH_RS1, 0); RUN(nv::PH_XN1, 0); RUN(nv::PH_PROJ, 0); RUN(nv::PH_ROPE, 0); RUN(nv::PH_ISC, 0); RUN(nv::PH_SEL, 0);
    for (int h = 0; h < nv::AH; ++h) { RUN(nv::PH_SC, h); RUN(nv::PH_ML, h); RUN(nv::PH_OA, h); }
    RUN(nv::PH_CONV, 0); RUN(nv::PH_L2, 0); RUN(nv::PH_BG, 0); RUN(nv::PH_GC, 0); RUN(nv::PH_AMAT, 0); RUN(nv::PH_SOL, 0); RUN(nv::PH_ATT, 0); RUN(nv::PH_SCAN_INIT, 0); RUN(nv::PH_SCAN, 0);
    RUN(nv::PH_OBN, 0); RUN(nv::PH_MIXB, 0); RUN(nv::PH_X1, 0); RUN(nv::PH_RS2, 0); RUN(nv::PH_XN2, 0); RUN(nv::PH_HID, 0); RUN(nv::PH_X2, 0); RUN(nv::PH_RS3, 0); RUN(nv::PH_OUT, 0);
#undef RUN
  }
  (void)ph; (void)hh;
}

extern "C" void kernel_launch(void* const* d_in, const int* in_sizes, int n_in, void* d_out, int out_size, void* d_ws, size_t ws_size, hipStream_t stream) {
  nv::NP p{};
  p.x = (const float*)d_in[0]; p.g1 = (const float*)d_in[1]; p.w_in = (const float*)d_in[2]; p.conv_w = (const float*)d_in[3]; p.a_log = (const float*)d_in[4]; p.dt_bias = (const float*)d_in[5];
  p.gdn_g = (const float*)d_in[6]; p.w_out = (const float*)d_in[7]; p.g2 = (const float*)d_in[8]; p.w1 = (const float*)d_in[9]; p.w2 = (const float*)d_in[10]; p.gf = (const float*)d_in[11];
  p.out = (float*)d_out;
  size_t need = nv::carve(p, (unsigned char*)d_ws);
  if (need > ws_size) { fprintf(stderr, "ws too small: need %zu have %zu\n", need, ws_size); return; }
#if NAIVE_SINGLE_LAUNCH
  static int grid_blocks = 0;
  if (!grid_blocks) { int dev = 0, cus = 0, per_cu = 0; hipGetDevice(&dev); hipDeviceGetAttribute(&cus, hipDeviceAttributeMultiprocessorCount, dev);
    hipOccupancyMaxActiveBlocksPerMultiprocessor(&per_cu, k_all, 256, 0); if (per_cu > 4) per_cu = 4; grid_blocks = cus * per_cu; }
  void* args[] = {&p};
  hipError_t e = hipLaunchCooperativeKernel((void*)k_all, dim3(grid_blocks), dim3(256), args, 0, stream);
  if (e != hipSuccess) fprintf(stderr, "cooperative launch failed: %s (grid %d)\n", hipGetErrorString(e), grid_blocks);
#else
  int ph[64], hh[64]; int n = nv::program(ph, hh);
  for (int b = 0; b < nv::NB; ++b) for (int i = 0; i < n; ++i) hipLaunchKernelGGL(k_phase, dim3(2048), dim3(256), 0, stream, p, ph[i], b, hh[i]);
#endif
}
```

```cpp
#define NBUF 8
#include <hip/hip_runtime.h>
#include <cstdio>
#include <cstdint>
#include <math.h>
namespace nvm {
__host__ __device__ inline void sincos_acc(float ang, float* s, float* c) {
  double a = (double)ang;
  double kq = rint(a * 0.63661977236758134308);
  double r = a - kq * 1.57079632679489661923;
  double r2 = r * r;
  double sn = r * (1.0 + r2 * (-1.0 / 6 + r2 * (1.0 / 120 + r2 * (-1.0 / 5040 + r2 * (1.0 / 362880 + r2 * (-1.0 / 39916800 + r2 * (1.0 / 6227020800.0)))))));
  double cs = 1.0 + r2 * (-0.5 + r2 * (1.0 / 24 + r2 * (-1.0 / 720 + r2 * (1.0 / 40320 + r2 * (-1.0 / 3628800 + r2 * (1.0 / 479001600.0 + r2 * (-1.0 / 87178291200.0)))))));
  int q = ((int)kq) & 3;
  double ss = (q == 0) ? sn : (q == 1) ? cs : (q == 2) ? -sn : -cs;
  double cc = (q == 0) ? cs : (q == 1) ? -sn : (q == 2) ? -cs : sn;
  *s = (float)ss; *c = (float)cc;
}
__host__ __device__ inline float inv_freq_f(int i) { return 1.0f / powf(10000.0f, (float)i / 32.0f); }
}
namespace pg8 {
#define PG8_LAS __attribute__((address_space(3)))
typedef unsigned short bf16_t;
typedef short bf16x8 __attribute__((ext_vector_type(8)));
typedef float f32x4 __attribute__((ext_vector_type(4)));
typedef unsigned u32x4 __attribute__((ext_vector_type(4)));
constexpr int BM = 256, BK = 64, HALF = 128, HTB = HALF * BK * 2  , STAGE_BYTES = 8 * HTB, NXCD = 8, WGM = 8;

__host__ __device__ __forceinline__ int lds_byte(int r, int c) { const int st = (r >> 4) * 2 + (c >> 5), rr = r & 15, cc = c & 31, ob = rr * 64 + cc * 2; return st * 1024 + (ob ^ (((ob >> 9) & 1) << 5)); }
__host__ __device__ __forceinline__ void stage_rc(int b, int& R, int& C) { const int st = b / 1024, sb = b % 1024, swz = sb ^ (((sb >> 9) & 1) << 5); R = (st >> 1) * 16 + swz / 64; C = (st & 1) * 32 + (swz % 64) / 2; }
__host__ __device__ __forceinline__ int perm32(int rho) { const int n = rho >> 4, i = rho & 15; return 8 * (i >> 2) + 4 * n + (i & 3); }

struct Unit { int pm, pn; };
struct Gemm { const bf16_t* A; const bf16_t* Bt; int M, N, K; };

struct StaticOrder {
    int nM, nN, nwg, G, c;
    __host__ __device__ void init(int M, int N, int G_, int c_) { nM = M / BM; nN = N / BM; nwg = nM * nN; G = G_; c = c_; }
    __host__ __device__ bool next(int i, Unit& u) const {
        const long L = (long)i * G + c; if (L >= nwg) return false;
        int wgid = (int)L; { const int q = nwg / NXCD, r = nwg % NXCD, xcd = wgid % NXCD, off = wgid / NXCD; wgid = (xcd < r ? xcd * (q + 1) : r * (q + 1) + (xcd - r) * q) + off; }
        const int nig = WGM * nN, gid = wgid / nig, fm = gid * WGM, gsz = (nM - fm) < WGM ? (nM - fm) : WGM;
        u.pm = fm + ((wgid % nig) % gsz); u.pn = (wgid % nig) / gsz; return true;
    }
    __device__ __forceinline__ void a_ready(const Unit&) const {}
    __device__ __forceinline__ void done(const Unit&) const {}
};

__device__ __forceinline__ unsigned cvt_pk_bf16(float lo, float hi) { unsigned r; asm volatile("v_cvt_pk_bf16_f32 %0, %1, %2" : "=v"(r) : "v"(lo), "v"(hi)); return r; }
typedef float f32x2 __attribute__((ext_vector_type(2)));
template <class Epi, class Sched, bool ALIGN_EPI = false, bool SP2 = false>
__device__ __forceinline__ void gemm_phase(PG8_LAS unsigned char* lds, const Gemm g, const Sched& S, const Epi& E) {
    int tid_l = threadIdx.x; asm volatile("" : "+v"(tid_l));
    const int tid = tid_l, wid = __builtin_amdgcn_readfirstlane(tid >> 6), lane = tid & 63, wr = wid >> 2, wc = wid & 3, fr = lane & 15, fq = lane >> 4;
    const int K = g.K, nt = K / BK;
    unsigned voffA[2], voffB[2];
#pragma unroll
    for (int i = 0; i < 2; ++i) { int R, C; stage_rc(tid * 16 + i * 8192, R, C); const int Rb = Epi::PERM ? ((R & ~31) + perm32(R & 31)) : R;
        voffA[i] = (unsigned)(R * K + C) * 2u; voffB[i] = (unsigned)(Rb * K + C) * 2u; }
    const size_t kstep = (size_t)(BK * 2);
    const size_t hstep = (size_t)HALF * K * 2;
    const size_t tstep = 2 * hstep;
    const unsigned ldsw = (unsigned)wid * 1024u;
    const int aoff = lds_byte(wr * 64 + fr, fq * 8), boff = lds_byte(wc * 32 + fr, fq * 8);
#define PG8_SA(b, h) (((b) * 2 + (h)) * HTB)
#define PG8_SB(b, h) ((4 + (b) * 2 + (h)) * HTB)
#define PG8_STAGE(bufoff, gbase, voff) do { _Pragma("unroll") for (int _i = 0; _i < 2; ++_i) \
        __builtin_amdgcn_global_load_lds((const unsigned*)((const char*)(gbase) + (voff)[_i]), (PG8_LAS unsigned*)(lds + (bufoff) + ldsw + _i * 8192), 16, 0, 0); } while (0)
#define PG8_LDA(dst, b, h) do { _Pragma("unroll") for (int m = 0; m < 4; ++m) _Pragma("unroll") for (int k = 0; k < 2; ++k) dst[m][k] = *(const PG8_LAS bf16x8*)(lds + PG8_SA(b, h) + aoff + m * 2048 + k * 1024); } while (0)
#define PG8_LDB(dst, b, h) do { _Pragma("unroll") for (int n = 0; n < 2; ++n) _Pragma("unroll") for (int k = 0; k < 2; ++k) dst[n][k] = *(const PG8_LAS bf16x8*)(lds + PG8_SB(b, h) + boff + n * 2048 + k * 1024); } while (0)
#define PG8_MMA(ai, bj, At, Bt) do { __builtin_amdgcn_s_setprio(1); _Pragma("unroll") for (int m = 0; m < 4; ++m) _Pragma("unroll") for (int n = 0; n < 2; ++n) _Pragma("unroll") for (int k = 0; k < 2; ++k) \
        acc[ai][bj][m][n] = __builtin_amdgcn_mfma_f32_16x16x32_bf16(Bt[n][k], At[m][k], acc[ai][bj][m][n], 0, 0, 0); __builtin_amdgcn_s_setprio(0); } while (0)
#define PG8_WAIT_V(n) asm volatile("s_waitcnt vmcnt(" #n ")" ::: "memory")
#define PG8_WAIT_L(n) asm volatile("s_waitcnt lgkmcnt(" #n ")" ::: "memory")
#define PG8_BAR __builtin_amdgcn_s_barrier()
#define PG8_SCHED __builtin_amdgcn_sched_barrier(0)
    Unit cur, nxt; int ui = 0;
    if (!S.next(0, cur)) return;
    f32x4 acc[2][2][4][2];
#pragma unroll
    for (int a = 0; a < 2; ++a)
#pragma unroll
        for (int b = 0; b < 2; ++b)
#pragma unroll
            for (int m = 0; m < 4; ++m)
#pragma unroll
                for (int n = 0; n < 2; ++n) acc[a][b][m][n] = (f32x4){0.f, 0.f, 0.f, 0.f};
    bf16x8 At[4][2], B0[2][2], B1[2][2];
    const char* cA = (const char*)g.A + (size_t)cur.pm * tstep; const char* cB = (const char*)g.Bt + (size_t)cur.pn * tstep;
    S.a_ready(cur);
    if constexpr (SP2) {
        PG8_STAGE(PG8_SB(0, 0), cB, voffB); PG8_STAGE(PG8_SB(0, 1), cB + hstep, voffB); PG8_STAGE(PG8_SA(0, 0), cA, voffA); PG8_STAGE(PG8_SA(0, 1), cA + hstep, voffA);
        if (wr == 1) PG8_BAR;
        PG8_WAIT_V(2); PG8_BAR;
        PG8_STAGE(PG8_SB(1, 0), cB + kstep, voffB); PG8_STAGE(PG8_SA(1, 0), cA + kstep, voffA); PG8_STAGE(PG8_SB(1, 1), cB + hstep + kstep, voffB);
        PG8_WAIT_V(6); PG8_BAR;
    } else {
        PG8_STAGE(PG8_SB(0, 0), cB, voffB); PG8_STAGE(PG8_SA(0, 0), cA, voffA); PG8_STAGE(PG8_SB(0, 1), cB + hstep, voffB); PG8_STAGE(PG8_SA(0, 1), cA + hstep, voffA);
        if (wr == 1) PG8_BAR;
        PG8_WAIT_V(4); PG8_BAR;
        PG8_STAGE(PG8_SB(1, 0), cB + kstep, voffB); PG8_STAGE(PG8_SA(1, 0), cA + kstep, voffA); PG8_STAGE(PG8_SB(1, 1), cB + hstep + kstep, voffB);
        PG8_WAIT_V(6); PG8_BAR;
    }
    for (;;) {
        const bool has_next = S.next(ui + 1, nxt);
        const char* nA = has_next ? (const char*)g.A + (size_t)nxt.pm * tstep : cA; const char* nB = has_next ? (const char*)g.Bt + (size_t)nxt.pn * tstep : cB;
        for (int t = 0; t < nt; t += 2) {
            const bool last = (t == nt - 2);
            const char* a1 = cA + (size_t)(t + 1) * kstep;
            const char* a2 = last ? nA : cA + (size_t)(t + 2) * kstep; const char* b2 = last ? nB : cB + (size_t)(t + 2) * kstep;
            const char* a3 = a2 + kstep; const char* b3 = b2 + kstep;
            if (last && has_next) S.a_ready(nxt);
            if constexpr (SP2) {
            PG8_LDB(B0, 0, 0); PG8_LDB(B1, 0, 1); PG8_SCHED; PG8_LDA(At, 0, 0); PG8_STAGE(PG8_SA(1, 1), a1 + hstep, voffA);
            PG8_WAIT_V(8); PG8_WAIT_L(0); PG8_BAR; PG8_MMA(0, 0, At, B0); PG8_MMA(0, 1, At, B1); PG8_BAR; PG8_SCHED;
            PG8_LDA(At, 0, 1); PG8_STAGE(PG8_SB(0, 0), b2, voffB); PG8_STAGE(PG8_SB(0, 1), b2 + hstep, voffB); PG8_STAGE(PG8_SA(0, 0), a2, voffA);
            PG8_WAIT_V(8); PG8_WAIT_L(0); PG8_BAR; PG8_MMA(1, 0, At, B0); PG8_MMA(1, 1, At, B1); PG8_BAR; PG8_SCHED;
            PG8_LDB(B0, 1, 0); PG8_LDB(B1, 1, 1); PG8_SCHED; PG8_LDA(At, 1, 0); PG8_STAGE(PG8_SA(0, 1), a2 + hstep, voffA);
            PG8_WAIT_V(8); PG8_WAIT_L(0); PG8_BAR; PG8_MMA(0, 0, At, B0); PG8_MMA(0, 1, At, B1); PG8_BAR; PG8_SCHED;
            PG8_LDA(At, 1, 1); PG8_STAGE(PG8_SB(1, 0), b3, voffB); PG8_STAGE(PG8_SB(1, 1), b3 + hstep, voffB); PG8_STAGE(PG8_SA(1, 0), a3, voffA);
            PG8_WAIT_V(8); PG8_WAIT_L(0); PG8_BAR; PG8_MMA(1, 0, At, B0); PG8_MMA(1, 1, At, B1); PG8_BAR; PG8_SCHED;
            } else {
            PG8_LDB(B0, 0, 0); PG8_SCHED; PG8_LDA(At, 0, 0); PG8_STAGE(PG8_SA(1, 1), a1 + hstep, voffA);
            PG8_WAIT_L(8); PG8_BAR; PG8_WAIT_L(0); PG8_MMA(0, 0, At, B0); PG8_BAR; PG8_SCHED;
            PG8_LDB(B1, 0, 1); PG8_STAGE(PG8_SB(0, 0), b2, voffB);
            PG8_BAR; PG8_WAIT_L(0); PG8_MMA(0, 1, At, B1); PG8_BAR;
            PG8_LDA(At, 0, 1); PG8_STAGE(PG8_SA(0, 0), a2, voffA);
            PG8_BAR; PG8_WAIT_L(0); PG8_MMA(1, 0, At, B0); PG8_BAR; PG8_SCHED;
            PG8_STAGE(PG8_SB(0, 1), b2 + hstep, voffB);
            PG8_WAIT_V(6); PG8_BAR; PG8_MMA(1, 1, At, B1); PG8_BAR;
            PG8_LDB(B0, 1, 0); PG8_SCHED; PG8_LDA(At, 1, 0); PG8_STAGE(PG8_SA(0, 1), a2 + hstep, voffA);
            PG8_WAIT_L(8); PG8_BAR; PG8_WAIT_L(0); PG8_MMA(0, 0, At, B0); PG8_BAR; PG8_SCHED;
            PG8_LDB(B1, 1, 1); PG8_STAGE(PG8_SB(1, 0), b3, voffB);
            PG8_BAR; PG8_WAIT_L(0); PG8_MMA(0, 1, At, B1); PG8_BAR;
            PG8_LDA(At, 1, 1); PG8_STAGE(PG8_SA(1, 0), a3, voffA);
            PG8_BAR; PG8_WAIT_L(0); PG8_MMA(1, 0, At, B0); PG8_BAR; PG8_SCHED;
            PG8_STAGE(PG8_SB(1, 1), b3 + hstep, voffB);
            PG8_WAIT_V(6); PG8_BAR; PG8_MMA(1, 1, At, B1); PG8_BAR;
            }
        }
        if constexpr (ALIGN_EPI) { if (wr == 0) PG8_BAR; }
        if constexpr (!Epi::AFTER_DRAIN) { E(acc, cur, wr, wc, fr, fq); S.done(cur); }
        if (!has_next) break;
#pragma unroll
        for (int a = 0; a < 2; ++a)
#pragma unroll
            for (int b = 0; b < 2; ++b)
#pragma unroll
                for (int m = 0; m < 4; ++m)
#pragma unroll
                    for (int n = 0; n < 2; ++n) acc[a][b][m][n] = (f32x4){0.f, 0.f, 0.f, 0.f};
        cur = nxt; cA = nA; cB = nB; ++ui;
        if constexpr (ALIGN_EPI) { if (wr == 1) PG8_BAR; }
    }
    PG8_WAIT_V(0);
    if constexpr (!ALIGN_EPI) { if (wr == 0) PG8_BAR; }
    PG8_BAR;
    if constexpr (Epi::AFTER_DRAIN) { E.fused(acc, cur, wr, wc, fr, fq, lds, wid, lane); S.done(cur); }
#undef PG8_SA
#undef PG8_SB
#undef PG8_STAGE
#undef PG8_LDA
#undef PG8_LDB
#undef PG8_MMA
#undef PG8_WAIT_V
#undef PG8_WAIT_L
#undef PG8_BAR
#undef PG8_SCHED
}
}
#define GAS __attribute__((address_space(1)))
#define LAS __attribute__((address_space(3)))
typedef unsigned short bf16;
typedef unsigned v4u __attribute__((ext_vector_type(4)));
typedef float f32x4 __attribute__((ext_vector_type(4)));
typedef short bf16x8 __attribute__((ext_vector_type(8)));
typedef GAS unsigned gu32;
typedef GAS unsigned long long gu64;
#define RLX_AGENT __ATOMIC_RELAXED, __HIP_MEMORY_SCOPE_AGENT
#define LDS_WAIT() asm volatile("s_waitcnt lgkmcnt(0)" ::: "memory")
#define VM_WAIT() asm volatile("s_waitcnt vmcnt(0)" ::: "memory")
__device__ __forceinline__ unsigned long long rt() { return __builtin_amdgcn_s_memrealtime(); }
__device__ __forceinline__ unsigned f2bf(float f) { unsigned u = __builtin_bit_cast(unsigned, f); return (u + 0x7fffu + ((u >> 16) & 1u)) >> 16; }
__device__ __forceinline__ unsigned pk2(float lo, float hi) { return f2bf(lo) | (f2bf(hi) << 16); }

#define XB_TMO      128
#define XB_XCNT(j)  (256  + 64 * (j))
#define XB_XSUB(j)  (1280 + 64 * (j))
#define XB_XGEN(j)  (2304 + 64 * (j))
#define XB_TOP      3328
#define XB_TOPGEN   3392
#define XCD_BAR_WORDS 3456
#ifndef XB_SPIN_CAP
#define XB_SPIN_CAP (1u << 18)
#endif

__device__ __forceinline__ unsigned xb_ld(unsigned* p)              { return __hip_atomic_load(p, __ATOMIC_RELAXED, __HIP_MEMORY_SCOPE_AGENT); }
__device__ __forceinline__ unsigned xb_add(unsigned* p, unsigned v) { return __hip_atomic_fetch_add(p, v, __ATOMIC_RELAXED, __HIP_MEMORY_SCOPE_AGENT); }
__device__ __forceinline__ unsigned xb_xcc_id() { return (unsigned)__builtin_amdgcn_s_getreg((3 << 11) | 20) & 0xFu; }
#define XB_SPIN(cond, bar) do { unsigned _sp = 0; while (cond) { __builtin_amdgcn_s_sleep(1); \
    if ((++_sp & 255u) == 0u) { if (xb_ld(&(bar)[XB_TMO])) break; if (_sp > XB_SPIN_CAP) { atomicAdd(&(bar)[XB_TMO], 1u); break; } } } } while (0)

struct XcdBarrier {
    unsigned* bar; unsigned x;
    volatile LAS unsigned* st;
};

__device__ __forceinline__ XcdBarrier xcd_barrier_post(unsigned* bar, volatile LAS unsigned* st) {
    XcdBarrier b; b.bar = bar; b.x = xb_xcc_id(); b.st = st;
    if (threadIdx.x == 0) (void)xb_add(&bar[XB_XCNT(b.x)], 1u);
    return b;
}
__device__ __forceinline__ void xcd_barrier_complete(unsigned* bar, unsigned x, unsigned& nloc, unsigned& nx) {
    const unsigned G = gridDim.x * gridDim.y * gridDim.z;
    unsigned sum, cnt, mine, sp = 0u;
    for (;;) {
        sum = 0u; cnt = 0u; mine = 0u;
#pragma unroll
        for (unsigned j = 0; j < 16; ++j) { const unsigned c = xb_ld(&bar[XB_XCNT(j)]); sum += c; cnt += (c > 0u) ? 1u : 0u; mine = (j == x) ? c : mine; }
        if (sum == G) break;
        __builtin_amdgcn_s_sleep(1);
        if ((++sp & 255u) == 0u) { if (xb_ld(&bar[XB_TMO])) break; if (sp > XB_SPIN_CAP) { atomicAdd(&bar[XB_TMO], 1u); break; } }
    }
    nloc = mine > 0u ? mine : 1u; nx = cnt > 0u ? cnt : 1u;
}

__device__ __forceinline__ void xcd_barrier(const XcdBarrier& b) {
    asm volatile("s_waitcnt vmcnt(0)" ::: "memory");
    __syncthreads();
    if (threadIdx.x == 0) {
        unsigned* bar = b.bar;
        __builtin_amdgcn_s_waitcnt(0);
        unsigned nloc = b.st[0], nx = b.st[1];
        if (nloc == 0u) { xcd_barrier_complete(bar, b.x, nloc, nx); b.st[0] = nloc; b.st[1] = nx; }
        const unsigned old = xb_add(&bar[XB_XSUB(b.x)], 1u);
        const unsigned gen = old / nloc;
        if (old + 1u == (gen + 1u) * nloc) {
            __builtin_amdgcn_fence(__ATOMIC_RELEASE, "agent");
            asm volatile("s_waitcnt vmcnt(0)" ::: "memory");
            const unsigned og = xb_add(&bar[XB_TOP], 1u);
            const unsigned tg = og / nx;
            if (og + 1u == (tg + 1u) * nx) xb_add(&bar[XB_TOPGEN], 1u);
            else XB_SPIN(xb_ld(&bar[XB_TOPGEN]) == tg, bar);
            __builtin_amdgcn_fence(__ATOMIC_ACQUIRE, "agent");
            xb_add(&bar[XB_XGEN(b.x)], 1u);
            asm volatile("s_waitcnt vmcnt(0)" ::: "memory");
        } else {
            XB_SPIN(xb_ld(&bar[XB_XGEN(b.x)]) == gen, bar);
            __builtin_amdgcn_fence(__ATOMIC_ACQUIRE, "agent");
            asm volatile("s_waitcnt vmcnt(0)" ::: "memory");
        }
    }
    __syncthreads();
}
#ifndef NBUF
#define NBUF 8
#endif
namespace fx {
constexpr int NB = 8, T = 2048, D = 1024, FF = 4096, MB = NBUF * T;
constexpr int NPROJ = 3584;
constexpr float C2 = 0.125f * 1.4426950408889634f;
constexpr float WSCALE = 0.35355339059327373f * 0.125f;
constexpr float EPS = 1e-6f;
constexpr int NWAVES = 8;
constexpr size_t MiB = 1u << 20;
constexpr size_t WS_CTL = 0, CTL_ZERO_BYTES = 1 * MiB;
constexpr size_t WS_WIN = 1 * MiB;
constexpr size_t WS_WOUT = 8 * MiB;
constexpr size_t WS_W1 = 10 * MiB;
constexpr size_t WS_W2 = 18 * MiB;
constexpr size_t WS_ROPE = 26 * MiB;
constexpr size_t WS_RS1 = WS_ROPE + 512 * 1024;
constexpr size_t WS_SSQ2 = WS_RS1 + 64 * 1024;
constexpr size_t WS_SSQ3 = WS_SSQ2 + 256 * 1024;
constexpr size_t WS_SMALL = WS_SSQ3 + 256 * 1024;
constexpr size_t WS_WI = WS_SMALL, WS_BETA = WS_WI + 512 * 1024, WS_GG = WS_BETA + 256 * 1024, WS_GC = WS_GG + 256 * 1024;
constexpr size_t WS_BUF0 = 29 * MiB;
static_assert(WS_GC + 256 * 1024 <= WS_BUF0, "small region");
constexpr size_t RB = (size_t)MB;
constexpr size_t WS_XB = WS_BUF0;
constexpr size_t WS_QA = WS_XB + RB * 1024 * 2;
constexpr size_t WS_KA = WS_QA + RB * 512 * 2;
constexpr size_t WS_VA = WS_KA + RB * 128 * 2;
constexpr size_t WS_QI = WS_VA + RB * 128 * 2;
constexpr size_t WS_KI = WS_QI + RB * 512 * 2;
constexpr size_t WS_QB4 = WS_KI + RB * 64 * 2;
constexpr size_t WS_MIX = WS_QB4 + 4 * RB * 512 * 2;
constexpr size_t WS_FAST_END = WS_MIX + RB * 1024 * 2;
}

struct Frame {
    LAS unsigned char* lds;
    volatile LAS unsigned* MISC;
    gu32* ctl;
    int tid, lane, wave, vcu, G;
    unsigned char* ws;
    const float *x, *g1, *w_in, *conv_w, *a_log, *dt_bias, *gdn_g, *w_out, *g2, *w1, *w2, *gf;
    float* out;
};
constexpr int RING_OFF = 0, RING_BYTES = 131072;
constexpr int LDS_BYTES = 163840;
constexpr int LDSCTL_OFF = LDS_BYTES - 512, MISC_OFF = LDSCTL_OFF + 320;
constexpr int CW_TMO = 0, CW_CODE = 1, CW_BAR = 4096;

__device__ __forceinline__ float wave_sum(float v) {
#pragma unroll
    for (int o = 1; o < 64; o <<= 1) v += __shfl_xor(v, o);
    return v;
}

__host__ __device__ __forceinline__ int proj_src_col(int n) {
    auto il = [](int j) { return (j & 1) ? (j >> 1) + 32 : (j >> 1); };
    if (n < 512) return 0 + (n & ~63) + il(n & 63);
    if (n < 640) return 512 + ((n - 512) & ~63) + il((n - 512) & 63);
    if (n < 768) return 640 + (n - 640);
    if (n < 1280) return 768 + ((n - 768) & ~63) + il((n - 768) & 63);
    if (n < 3328) return 1352 + (n - 1280);
    if (n < 3392) return 1280 + il(n - 3328);
    if (n < 3400) return 1344 + (n - 3392);
    if (n < 3408) return n;
    return -1;
}
template <int MAP>
__device__ __forceinline__ void p0_transpose_item(const float* W, int K, int N, int NP_, const float* gk, bf16* WT, LAS float* scr, int item, int lane) {
    const int nblk = NP_ / 32, kb = item / nblk, nb = item % nblk, k0 = 64 * kb, n0 = 32 * nb;
    const int nn = n0 + (lane & 31); const int src = MAP ? proj_src_col(nn) : nn;
#pragma unroll 8
    for (int i = 0; i < 32; ++i) { const int kk = 2 * i + (lane >> 5); float v = 0.f; if (src >= 0) { v = W[(size_t)(k0 + kk) * N + src]; if (gk) v *= gk[k0 + kk]; } scr[kk * 33 + (lane & 31)] = v; }
    LDS_WAIT(); asm volatile("" ::: "memory");
    const int c = lane & 7;
#pragma unroll
    for (int j = 0; j < 4; ++j) { const int n = (lane >> 3) + 8 * j; const LAS float* s = scr + (8 * c) * 33 + n;
        v4u o; o.x = pk2(s[0 * 33], s[1 * 33]); o.y = pk2(s[2 * 33], s[3 * 33]); o.z = pk2(s[4 * 33], s[5 * 33]); o.w = pk2(s[6 * 33], s[7 * 33]);
        *(GAS v4u*)(WT + (size_t)(n0 + n) * K + k0 + 8 * c) = o; }
    LDS_WAIT(); asm volatile("" ::: "memory");
}
__device__ __forceinline__ void row_to_bf16_rs(Frame& F, const float* xrow, bf16* orow, float* rs) {
    const GAS f32x4* xr = (const GAS f32x4*)xrow + F.lane;
    f32x4 v[4]; float s = 0.f;
#pragma unroll
    for (int j = 0; j < 4; ++j) { v[j] = xr[64 * j]; s += (v[j].x * v[j].x + v[j].y * v[j].y) + (v[j].z * v[j].z + v[j].w * v[j].w); }
    s = wave_sum(s);
    GAS unsigned long long* o8 = (GAS unsigned long long*)orow + F.lane;
#pragma unroll
    for (int j = 0; j < 4; ++j) o8[64 * j] = (unsigned long long)pk2(v[j].x, v[j].y) | ((unsigned long long)pk2(v[j].z, v[j].w) << 32);
    if (F.lane == 0) *rs = 1.0f / sqrtf(s * (1.0f / fx::D) + fx::EPS);
}
__device__ __forceinline__ void p0_weights(Frame& F) {
    using namespace fx;
    LAS float* scr = (LAS float*)(F.lds + RING_OFF + F.wave * 16384);
    const int gw = F.vcu * NWAVES + F.wave, NGW = F.G * NWAVES;
    constexpr int I_IN = (D / 64) * (NPROJ / 32), I_O = (D / 64) * (D / 32), I_1 = (D / 64) * (FF / 32), I_2 = (FF / 64) * (D / 32);
    constexpr int NITEMS = I_IN + I_O + I_1 + I_2;
    bf16* Win = (bf16*)(F.ws + WS_WIN); bf16* Wo = (bf16*)(F.ws + WS_WOUT); bf16* W1 = (bf16*)(F.ws + WS_W1); bf16* W2 = (bf16*)(F.ws + WS_W2);
    for (int it = gw; it < NITEMS; it += NGW) {
        int r = it;
        if (r < I_IN) { p0_transpose_item<1>(F.w_in, D, 3408, NPROJ, F.g1, Win, scr, r, F.lane); continue; } r -= I_IN;
        if (r < I_O) { p0_transpose_item<0>(F.w_out, D, D, D, nullptr, Wo, scr, r, F.lane); continue; } r -= I_O;
        if (r < I_1) { p0_transpose_item<0>(F.w1, D, FF, FF, F.g2, W1, scr, r, F.lane); continue; } r -= I_1;
        p0_transpose_item<0>(F.w2, FF, D, D, nullptr, W2, scr, r, F.lane);
    }
    float* rope = (float*)(F.ws + WS_ROPE);
    for (int i = F.vcu * 512 + F.tid; i < T * 32; i += F.G * 512) { const int t = i >> 5, j = i & 31; float sn, cs; nvm::sincos_acc((float)t * nvm::inv_freq_f(j), &sn, &cs); rope[2 * i] = cs; rope[2 * i + 1] = sn; }
}
__device__ __forceinline__ void p0_rows(Frame& F, int brow0) {
    using namespace fx;
    const int gw = F.vcu * NWAVES + F.wave, NGW = F.G * NWAVES;
    bf16* XB = (bf16*)(F.ws + WS_XB); float* RS1 = (float*)(F.ws + WS_RS1);
    for (int m = gw; m < MB; m += NGW) row_to_bf16_rs(F, F.x + (size_t)(brow0 + m) * D, XB + (size_t)m * D, RS1 + m);
}

namespace pg8 {
struct EpiProj {
    static constexpr bool PERM = true, AFTER_DRAIN = false;
    unsigned char* ws; const float* a_log; const float* dt_bias;
    __device__ __forceinline__ void operator()(const f32x4 (&acc)[2][2][4][2], const Unit& u, int wr, int wc, int fr, int fq) const {
        using namespace fx;
        const int pn = u.pn;
        const float* RS1 = (const float*)(ws + WS_RS1); const float* ROPE = (const float*)(ws + WS_ROPE);
        const int i0 = (wc & 1) * 16 + 4 * fq;
        const int cb = wc * 32 + 8 * fq;
        const int row0 = u.pm * BM + wr * 64 + fr;
        if (pn == 13) {
            if (wc < 2) {
                bf16_t* dst = (bf16_t*)(ws + WS_KI) + cb;
#pragma unroll
                for (int ai = 0; ai < 2; ++ai)
#pragma unroll
                    for (int m = 0; m < 4; ++m) {
                        const int row = row0 + ai * HALF + m * 16; const float r = RS1[row];
                        const float* rp = ROPE + ((size_t)(row & (T - 1)) * 32 + i0) * 2; const f32x4 ca = *(const f32x4*)rp, cc = *(const f32x4*)(rp + 4);
                        const f32x4 v0 = acc[ai][0][m][0] * r, v1 = acc[ai][0][m][1] * r; u32x4 w;
                        w.x = cvt_pk_bf16(v0[0] * ca[0] - v0[1] * ca[1], v0[1] * ca[0] + v0[0] * ca[1]); w.y = cvt_pk_bf16(v0[2] * ca[2] - v0[3] * ca[3], v0[3] * ca[2] + v0[2] * ca[3]);
                        w.z = cvt_pk_bf16(v1[0] * cc[0] - v1[1] * cc[1], v1[1] * cc[0] + v1[0] * cc[1]); w.w = cvt_pk_bf16(v1[2] * cc[2] - v1[3] * cc[3], v1[3] * cc[2] + v1[2] * cc[3]);
                        *(u32x4*)(dst + (size_t)row * 64) = w;
                        if (m & 1) asm volatile("" ::: "memory");
                    }
            } else if (wc == 2 && fq < 2) {
#pragma unroll
                for (int ai = 0; ai < 2; ++ai)
#pragma unroll
                    for (int m = 0; m < 4; ++m) {
                        const int row = row0 + ai * HALF + m * 16; const float r = RS1[row];
                        const f32x4 v0 = acc[ai][0][m][0] * r, v1 = acc[ai][0][m][1] * r;
                        if (fq == 0) { float* w = (float*)(ws + WS_WI) + (size_t)row * 8; *(f32x4*)w = v0 * WSCALE; *(f32x4*)(w + 4) = v1 * WSCALE; }
                        else { f32x4 be, gg;
#pragma unroll
                            for (int j = 0; j < 4; ++j) { be[j] = 1.0f / (1.0f + __expf(-v0[j])); const float z = v1[j] + dt_bias[j]; const float sp = fmaxf(z, 0.f) + log1pf(__expf(-fabsf(z))); gg[j] = -__expf(a_log[j]) * sp; }
                            *(f32x4*)((float*)(ws + WS_BETA) + (size_t)row * 4) = be; *(f32x4*)((float*)(ws + WS_GG) + (size_t)row * 4) = gg; }
                        asm volatile("" ::: "memory");
                    }
            }
            return;
        }
        bf16_t* d0; bf16_t* d1; int ld; bool rope0, rope1; float sc = 1.f;
        if (pn < 2) { d0 = (bf16_t*)(ws + WS_QA) + pn * 256 + cb; d1 = d0 + 128; ld = 512; rope0 = rope1 = true; sc = C2; }
        else if (pn == 2) { d0 = (bf16_t*)(ws + WS_KA) + cb; d1 = (bf16_t*)(ws + WS_VA) + cb; ld = 128; rope0 = true; rope1 = false; }
        else if (pn < 5) { d0 = (bf16_t*)(ws + WS_QI) + (pn - 3) * 256 + cb; d1 = d0 + 128; ld = 512; rope0 = rope1 = true; }
        else { d0 = (bf16_t*)(ws + WS_QB4) + (size_t)((pn - 5) >> 1) * RB * 512 + ((pn - 5) & 1) * 256 + cb; d1 = d0 + 128; ld = 512; rope0 = rope1 = false; }
#pragma unroll
        for (int ai = 0; ai < 2; ++ai)
#pragma unroll
            for (int m = 0; m < 4; ++m) {
                const int row = row0 + ai * HALF + m * 16; const float r = RS1[row] * sc;
                f32x4 ca = (f32x4){1.f, 0.f, 1.f, 0.f}, cc = ca;
                if (rope0) { const float* rp = ROPE + ((size_t)(row & (T - 1)) * 32 + i0) * 2; ca = *(const f32x4*)rp; cc = *(const f32x4*)(rp + 4); }
#pragma unroll
                for (int bj = 0; bj < 2; ++bj) {
                    const f32x4 v0 = acc[ai][bj][m][0] * r, v1 = acc[ai][bj][m][1] * r; u32x4 w;
                    if (bj == 0 ? rope0 : rope1) {
                        w.x = cvt_pk_bf16(v0[0] * ca[0] - v0[1] * ca[1], v0[1] * ca[0] + v0[0] * ca[1]); w.y = cvt_pk_bf16(v0[2] * ca[2] - v0[3] * ca[3], v0[3] * ca[2] + v0[2] * ca[3]);
                        w.z = cvt_pk_bf16(v1[0] * cc[0] - v1[1] * cc[1], v1[1] * cc[0] + v1[0] * cc[1]); w.w = cvt_pk_bf16(v1[2] * cc[2] - v1[3] * cc[3], v1[3] * cc[2] + v1[2] * cc[3]);
                    } else { w.x = cvt_pk_bf16(v0[0], v0[1]); w.y = cvt_pk_bf16(v0[2], v0[3]); w.z = cvt_pk_bf16(v1[0], v1[1]); w.w = cvt_pk_bf16(v1[2], v1[3]); }
                    *(u32x4*)((bj == 0 ? d0 : d1) + (size_t)row * ld) = w;
                }
                if (m & 1) asm volatile("" ::: "memory");
            }
    }
};
}

__device__ __forceinline__ float bf2f(bf16 v) { return __builtin_bit_cast(float, (unsigned)v << 16); }
#ifdef HYBRID
__device__ __forceinline__ void convert_a(Frame& F, const nv::NP& p, long tid, long nth) {
    using namespace fx;
    for (long i = tid; i < (long)T * 3408; i += nth) {
        const int t = (int)(i / 3408), n = (int)(i % 3408); float v;
        auto il = [](int d) { return d < 32 ? 2 * d : 2 * (d - 32) + 1; };
        if (n < 512) v = bf2f(((const bf16*)(F.ws + WS_QA))[(size_t)t * 512 + (n & ~63) + il(n & 63)]) * (1.0f / C2);
        else if (n < 640) v = bf2f(((const bf16*)(F.ws + WS_KA))[(size_t)t * 128 + ((n - 512) & ~63) + il((n - 512) & 63)]);
        else if (n < 768) v = bf2f(((const bf16*)(F.ws + WS_VA))[(size_t)t * 128 + (n - 640)]);
        else if (n < 1280) v = bf2f(((const bf16*)(F.ws + WS_QI))[(size_t)t * 512 + ((n - 768) & ~63) + il((n - 768) & 63)]);
        else if (n < 1344) v = bf2f(((const bf16*)(F.ws + WS_KI))[(size_t)t * 64 + il(n - 1280)]);
        else if (n < 1352) v = ((const float*)(F.ws + WS_WI))[(size_t)t * 8 + (n - 1344)] * (1.0f / WSCALE);
        else if (n < 3400) { const int c = n - 1352; v = bf2f(((const bf16*)(F.ws + WS_QB4))[(size_t)(c >> 9) * RB * 512 + (size_t)t * 512 + (c & 511)]); }
        else v = 0.f;
        p.proj[i] = v;
    }
    for (long i = tid; i < (long)T * 4; i += nth) { p.bg[i * 3 + 0] = ((const float*)(F.ws + WS_BETA))[i]; p.bg[i * 3 + 1] = ((const float*)(F.ws + WS_GG))[i]; }
}
#endif
namespace fx {
constexpr size_t WS_HID = WS_QA;
static_assert(WS_HID + RB * 4096 * 2 <= 256 * MiB, "hid fits");
constexpr size_t WS_SSQ2W = WS_SSQ2;
}
namespace fx { constexpr size_t WS_SQ2 = (NBUF == 8) ? 200 * MiB : WS_SSQ2, WS_SQ3 = (NBUF == 8) ? 201 * MiB : WS_SSQ3; static_assert(NBUF == 1 || NBUF == 8, "NBUF"); static_assert(NBUF < 8 || (WS_MIX + RB * 1024 * 2 <= WS_SQ2), "sq region clear of MIX"); }
namespace pg8 {
struct EpiOut {
    static constexpr bool PERM = true, AFTER_DRAIN = false;
    unsigned char* ws; const float* xres; float* x1; int brow0;
    __device__ __forceinline__ void operator()(const f32x4 (&acc)[2][2][4][2], const Unit& u, int wr, int wc, int fr, int fq) const {
        using namespace fx;
        const int c0 = u.pn * BM + wc * 32 + 8 * fq; const int row0 = u.pm * BM + wr * 64 + fr;
        bf16_t* XB = (bf16_t*)(ws + WS_XB); float* SQ = (float*)(ws + WS_SQ2);
#pragma unroll
        for (int ai = 0; ai < 2; ++ai)
#pragma unroll
            for (int m = 0; m < 4; ++m) {
                const int row = row0 + ai * HALF + m * 16; const size_t go = (size_t)(brow0 + row) * D + c0; float ss = 0.f;
#pragma unroll
                for (int bj = 0; bj < 2; ++bj) {
                    const f32x4 v0 = acc[ai][bj][m][0] + *(const f32x4*)(xres + go + bj * HALF), v1 = acc[ai][bj][m][1] + *(const f32x4*)(xres + go + bj * HALF + 4);
                    *(f32x4*)(x1 + go + bj * HALF) = v0; *(f32x4*)(x1 + go + bj * HALF + 4) = v1;
                    ss += (v0[0] * v0[0] + v0[1] * v0[1]) + (v0[2] * v0[2] + v0[3] * v0[3]) + (v1[0] * v1[0] + v1[1] * v1[1]) + (v1[2] * v1[2] + v1[3] * v1[3]);
                    if (XB) { u32x4 w; w.x = cvt_pk_bf16(v0[0], v0[1]); w.y = cvt_pk_bf16(v0[2], v0[3]); w.z = cvt_pk_bf16(v1[0], v1[1]); w.w = cvt_pk_bf16(v1[2], v1[3]);
                        *(u32x4*)(XB + (size_t)row * D + c0 + bj * HALF) = w; }
                }
                ss += __shfl_xor(ss, 16); ss += __shfl_xor(ss, 32);
                if (fq == 0) SQ[(size_t)row * 16 + u.pn * 4 + wc] = ss;
                if (m & 1) asm volatile("" ::: "memory");
            }
    }
};
struct EpiFF1 {
    static constexpr bool PERM = true, AFTER_DRAIN = false;
    unsigned char* ws;
    __device__ __forceinline__ void operator()(const f32x4 (&acc)[2][2][4][2], const Unit& u, int wr, int wc, int fr, int fq) const {
        using namespace fx;
        const int c0 = u.pn * BM + wc * 32 + 8 * fq; const int row0 = u.pm * BM + wr * 64 + fr;
        bf16_t* HID = (bf16_t*)(ws + WS_HID); const float* SQ = (const float*)(ws + WS_SQ2);
#pragma unroll
        for (int ai = 0; ai < 2; ++ai)
#pragma unroll
            for (int m = 0; m < 4; ++m) {
                const int row = row0 + ai * HALF + m * 16;
                const f32x4 q0 = *(const f32x4*)(SQ + (size_t)row * 16), q1 = *(const f32x4*)(SQ + (size_t)row * 16 + 4), q2 = *(const f32x4*)(SQ + (size_t)row * 16 + 8), q3 = *(const f32x4*)(SQ + (size_t)row * 16 + 12);
                const f32x4 qs = (q0 + q1) + (q2 + q3); const float r = 1.0f / sqrtf(((qs[0] + qs[1]) + (qs[2] + qs[3])) * (1.0f / D) + EPS);
#pragma unroll
                for (int bj = 0; bj < 2; ++bj) {
                    f32x4 v0 = acc[ai][bj][m][0] * r, v1 = acc[ai][bj][m][1] * r;
#pragma unroll
                    for (int j = 0; j < 4; ++j) { v0[j] = fmaxf(v0[j], 0.f); v0[j] *= v0[j]; v1[j] = fmaxf(v1[j], 0.f); v1[j] *= v1[j]; }
                    u32x4 w; w.x = cvt_pk_bf16(v0[0], v0[1]); w.y = cvt_pk_bf16(v0[2], v0[3]); w.z = cvt_pk_bf16(v1[0], v1[1]); w.w = cvt_pk_bf16(v1[2], v1[3]);
                    *(u32x4*)(HID + (size_t)row * FF + c0 + bj * HALF) = w;
                }
                if (m & 1) asm volatile("" ::: "memory");
            }
    }
};
struct EpiFF2 {
    static constexpr bool PERM = true, AFTER_DRAIN = false;
    unsigned char* ws; float* x1; int brow0;
    __device__ __forceinline__ void operator()(const f32x4 (&acc)[2][2][4][2], const Unit& u, int wr, int wc, int fr, int fq) const {
        using namespace fx;
        const int c0 = u.pn * BM + wc * 32 + 8 * fq; const int row0 = u.pm * BM + wr * 64 + fr;
        float* SQ = (float*)(ws + WS_SQ3);
#pragma unroll
        for (int ai = 0; ai < 2; ++ai)
#pragma unroll
            for (int m = 0; m < 4; ++m) {
                const int row = row0 + ai * HALF + m * 16; const size_t go = (size_t)(brow0 + row) * D + c0; float ss = 0.f;
#pragma unroll
                for (int bj = 0; bj < 2; ++bj) {
                    const f32x4 v0 = acc[ai][bj][m][0] + *(const f32x4*)(x1 + go + bj * HALF), v1 = acc[ai][bj][m][1] + *(const f32x4*)(x1 + go + bj * HALF + 4);
                    *(f32x4*)(x1 + go + bj * HALF) = v0; *(f32x4*)(x1 + go + bj * HALF + 4) = v1;
                    ss += (v0[0] * v0[0] + v0[1] * v0[1]) + (v0[2] * v0[2] + v0[3] * v0[3]) + (v1[0] * v1[0] + v1[1] * v1[1]) + (v1[2] * v1[2] + v1[3] * v1[3]);
                }
                ss += __shfl_xor(ss, 16); ss += __shfl_xor(ss, 32);
                if (fq == 0) SQ[(size_t)row * 16 + u.pn * 4 + wc] = ss;
                if (m & 1) asm volatile("" ::: "memory");
            }
    }
};
}
__device__ __forceinline__ void p7_final(Frame& F, int brow0) {
    using namespace fx;
    const int gw = F.vcu * NWAVES + F.wave, NGW = F.G * NWAVES; const float* SQ = (const float*)(F.ws + WS_SQ3);
    for (int m = gw; m < MB; m += NGW) {
        float q = (F.lane < 16) ? SQ[(size_t)m * 16 + F.lane] : 0.f; q = wave_sum(q);
        const float r = 1.0f / sqrtf(q * (1.0f / D) + EPS);
        GAS f32x4* o = (GAS f32x4*)(F.out + (size_t)(brow0 + m) * D) + F.lane; const GAS f32x4* g = (const GAS f32x4*)F.gf + F.lane;
#pragma unroll
        for (int j = 0; j < 4; ++j) { f32x4 v = o[64 * j]; const f32x4 gg = g[64 * j]; v = v * r; v = v * gg; o[64 * j] = v; }
    }
}
__device__ __forceinline__ void phases_d(Frame& F, XcdBarrier& bar, int brow0) {
    using namespace fx;
    { pg8::Gemm g{(const pg8::bf16_t*)(F.ws + WS_MIX), (const pg8::bf16_t*)(F.ws + WS_WOUT), MB, D, D}; pg8::StaticOrder S; S.init(MB, D, F.G, (int)blockIdx.x);
      pg8::EpiOut E{F.ws, F.x, F.out, brow0}; pg8::gemm_phase<pg8::EpiOut, pg8::StaticOrder, true, true>(F.lds + RING_OFF, g, S, E); }
    xcd_barrier(bar);
    { pg8::Gemm g{(const pg8::bf16_t*)(F.ws + WS_XB), (const pg8::bf16_t*)(F.ws + WS_W1), MB, FF, D}; pg8::StaticOrder S; S.init(MB, FF, F.G, (int)blockIdx.x);
      pg8::EpiFF1 E{F.ws}; pg8::gemm_phase<pg8::EpiFF1, pg8::StaticOrder, true, true>(F.lds + RING_OFF, g, S, E); }
    xcd_barrier(bar);
    { pg8::Gemm g{(const pg8::bf16_t*)(F.ws + WS_HID), (const pg8::bf16_t*)(F.ws + WS_W2), MB, D, FF}; pg8::StaticOrder S; S.init(MB, D, F.G, (int)blockIdx.x);
      pg8::EpiFF2 E{F.ws, F.out, brow0}; pg8::gemm_phase<pg8::EpiFF2, pg8::StaticOrder, true, true>(F.lds + RING_OFF, g, S, E); }
    xcd_barrier(bar);
    p7_final(F, brow0);
}
#ifdef HYBRID
#ifndef MIXCOL0
#define MIXCOL0 0
#endif
__device__ __forceinline__ void convert_d(Frame& F, const nv::NP& p, long tid, long nth) {
    using namespace fx; bf16* MIX = (bf16*)(F.ws + WS_MIX);
    for (long i = tid; i < (long)T * D; i += nth) if ((i & 1023) >= MIXCOL0) MIX[i] = (bf16)f2bf(p.mix[i]);
}
#endif
namespace fx { constexpr size_t WS_SELM = (NBUF == 8) ? (WS_XB + 16 * MiB) : WS_FAST_END; }
__device__ __forceinline__ unsigned* selm_ptr(unsigned char* ws) { return (unsigned*)(ws + fx::WS_SELM); }

typedef float f32x4_t __attribute__((ext_vector_type(4)));
__device__ __forceinline__ unsigned ord_key(float v) { const unsigned u = __builtin_bit_cast(unsigned, v); return (u & 0x80000000u) ? ~u : (u | 0x80000000u); }

__device__ __forceinline__ void idx_unit(Frame& F, int row0) {
    using namespace fx;
    int lane_l = F.lane; asm volatile("" : "+v"(lane_l));
    const int lane = lane_l, w = F.wave;
    const int bl = row0 / T, t0 = row0 % T, chunk = t0 / 64, limit = (chunk + 1) * 64, ntile = limit / 16, nreg = chunk + 1;
    const bf16* KI = (const bf16*)(F.ws + WS_KI) + (size_t)bl * T * 64;
    const bf16* QI = (const bf16*)(F.ws + WS_QI) + (size_t)row0 * 512;
    const float* WI = (const float*)(F.ws + WS_WI) + (size_t)row0 * 8;
    LAS float* SC = (LAS float*)(F.lds);
    constexpr int SCS = 2052;
    const int q = lane & 15, g = lane >> 4;
    {
        bf16x8 bq[8][2];
#pragma unroll
        for (int h = 0; h < 8; ++h)
#pragma unroll
            for (int ks = 0; ks < 2; ++ks) bq[h][ks] = *(const bf16x8*)(QI + (size_t)q * 512 + h * 64 + ks * 32 + g * 8);
        const f32x4_t wa = *(const f32x4_t*)(WI + q * 8), wb = *(const f32x4_t*)(WI + q * 8 + 4);
        float wv[8] = {wa[0], wa[1], wa[2], wa[3], wb[0], wb[1], wb[2], wb[3]};
        for (int tile = w; tile < ntile; tile += 8) {
            const bf16* kp = KI + (size_t)(tile * 16 + q) * 64 + g * 8;
            const bf16x8 a0 = *(const bf16x8*)kp, a1 = *(const bf16x8*)(kp + 32);
            f32x4_t isc = {0.f, 0.f, 0.f, 0.f};
#pragma unroll
            for (int h = 0; h < 8; ++h) {
                f32x4_t d = __builtin_amdgcn_mfma_f32_16x16x32_bf16(a0, bq[h][0], (f32x4_t){0.f, 0.f, 0.f, 0.f}, 0, 0, 0);
                d = __builtin_amdgcn_mfma_f32_16x16x32_bf16(a1, bq[h][1], d, 0, 0, 0);
#pragma unroll
                for (int r = 0; r < 4; ++r) isc[r] += wv[h] * fmaxf(d[r], 0.f);
            }
            *(LAS f32x4_t*)(SC + q * SCS + tile * 16 + 4 * g) = isc;
        }
    }
    __syncthreads();
    unsigned* SELM = selm_ptr(F.ws);
#pragma unroll 1
    for (int qq = 0; qq < 2; ++qq) {
        const int qi = 2 * w + qq;
        unsigned key[32];
#pragma unroll
        for (int r = 0; r < 32; ++r) key[r] = (r < nreg) ? ord_key(SC[qi * SCS + r * 64 + lane]) : 0u;
        unsigned Tsel = 1u; int cge = 0;
        if (nreg > 4) {
            unsigned Tcur = 0u;
#pragma unroll 1
            for (int bit = 31; bit >= 0; --bit) {
                const unsigned cand = Tcur | (1u << bit); int c = 0;
#pragma unroll
                for (int r = 0; r < 32; ++r) c += __popcll(__ballot(key[r] >= cand));
                if (c >= 256) { Tcur = cand; cge = c; if (c == 256) break; }
            }
            Tsel = Tcur;
        }
        int excess = (nreg > 4) ? cge - 256 : 0;
        unsigned wv_ = 0u;
#pragma unroll
        for (int r = 31; r >= 0; --r) {
            unsigned long long m = (r < nreg) ? __ballot(key[r] >= Tsel) : 0ull;
            if (excess > 0) { unsigned long long e = __ballot(key[r] == Tsel);
                while (excess > 0 && e) { const int hb = 63 - __clzll(e); m &= ~(1ull << hb); e &= ~(1ull << hb); --excess; } }
            { const unsigned sel_w = (lane & 1) ? (unsigned)(m >> 32) : (unsigned)m; wv_ = ((lane >> 1) == r) ? sel_w : wv_; }
        }
        SELM[(size_t)(row0 + qi) * 64 + lane] = wv_;
    }
    __syncthreads();
}
__device__ __forceinline__ void idx_phase(Frame& F) {
    using namespace fx;
    const int nunit = MB / 16;
    for (int i = F.vcu; i < nunit; i += F.G) {
        const int per_chunk = NBUF * 4;
        const int chunk = 31 - i / per_chunk, r = i % per_chunk, bl = r / 4, g16 = r % 4;
        idx_unit(F, bl * T + chunk * 64 + g16 * 16);
    }
}
#ifdef HYBRID
__device__ __forceinline__ void convert_b1(Frame& F, const nv::NP& p, long tid, long nth) {
    using namespace fx; const unsigned* SELM = selm_ptr(F.ws);
    for (long i = tid; i < (long)T * T; i += nth) { const int t = (int)(i / T), s = (int)(i % T); p.sel[i] = (SELM[(size_t)t * 64 + (s >> 5)] >> (s & 31)) & 1u; }
}
#endif
namespace at {
using bf16x8 = __attribute__((ext_vector_type(8))) short;
using s16x4 = __attribute__((ext_vector_type(4))) short;
using f32x16 = __attribute__((ext_vector_type(16))) float;
using u32x4 = __attribute__((ext_vector_type(4))) unsigned;
using u32x2 = __attribute__((ext_vector_type(2))) unsigned;
constexpr int SLOTB = 8192, LDS_K = 0, LDS_V = 2 * SLOTB, LDS_WS = 4 * SLOTB, LDS_OST = LDS_WS + 8 * 256, LDS_MK = LDS_OST + 8 * 4096, MKS = 66, LDS_END = LDS_MK + 64 * MKS * 4;
__device__ __forceinline__ int crow(int r, int hi) { return (r & 3) + 8 * (r >> 2) + 4 * hi; }
__device__ __forceinline__ void glds16(const void* gsrc, unsigned lds_dst) { unsigned keep;
    asm volatile("s_mov_b32 %0, m0\n\ts_mov_b32 m0, %2\n\ts_nop 0\n\tglobal_load_lds_dwordx4 %1, off\n\ts_mov_b32 m0, %0" : "=&s"(keep) : "v"(gsrc), "s"(lds_dst) : "memory"); }
__device__ __forceinline__ float max3f(float a, float b, float c) { float r; asm("v_max3_f32 %0, %1, %2, %3" : "=v"(r) : "v"(a), "v"(b), "v"(c)); return r; }
typedef float f32x2_t __attribute__((ext_vector_type(2))); typedef __bf16 bf16x2_t __attribute__((ext_vector_type(2)));
__device__ __forceinline__ unsigned cvtpk_s(float lo, float hi) { f32x2_t v = {lo, hi}; bf16x2_t b = __builtin_convertvector(v, bf16x2_t); return __builtin_bit_cast(unsigned, b); }
__device__ __forceinline__ void qkt(f32x16& p0, f32x16& p1, const LAS char* Kslot, const bf16x8* qr, int r32, int hi) {
    const LAS char* kb = Kslot + hi * 1024 + r32 * 16; const f32x16 z = {};
#pragma unroll
    for (int d0 = 0; d0 < 4; ++d0) {
        const bf16x8 b0 = *(const LAS bf16x8*)(kb + d0 * 2048), b1 = *(const LAS bf16x8*)(kb + d0 * 2048 + 512);
        if (d0 == 0) { p0 = __builtin_amdgcn_mfma_f32_32x32x16_bf16(b0, qr[0], z, 0, 0, 0); p1 = __builtin_amdgcn_mfma_f32_32x32x16_bf16(b1, qr[0], z, 0, 0, 0); }
        else { p0 = __builtin_amdgcn_mfma_f32_32x32x16_bf16(b0, qr[d0], p0, 0, 0, 0); p1 = __builtin_amdgcn_mfma_f32_32x32x16_bf16(b1, qr[d0], p1, 0, 0, 0); } }
}
__device__ __forceinline__ float rowmax(const f32x16& p0, const f32x16& p1) {
    float a = max3f(p0[0], p0[1], p1[0]), b = max3f(p0[2], p0[3], p1[1]); a = max3f(a, p1[2], p1[3]);
#pragma unroll
    for (int r = 4; r < 16; r += 4) { a = max3f(a, p0[r], p0[r + 1]); b = max3f(b, p0[r + 2], p0[r + 3]); a = max3f(a, p1[r], p1[r + 1]); b = max3f(b, p1[r + 2], p1[r + 3]); }
    const float m = fmaxf(a, b);
    auto rr = __builtin_amdgcn_permlane32_swap(__float_as_uint(m), __float_as_uint(m), false, false);
    return fmaxf(__uint_as_float(rr[0]), __uint_as_float(rr[1]));
}
__device__ __forceinline__ void pv(f32x16* o, int vb, bf16x8 pa0, bf16x8 pa1, bf16x8 pa2, bf16x8 pa3) {
#pragma unroll
    for (int d0 = 0; d0 < 2; ++d0) { s16x4 lo[4], hi[4];
#pragma unroll
        for (int ks = 0; ks < 4; ++ks) {
            asm volatile("ds_read_b64_tr_b16 %0,%1 offset:%c2" : "=&v"(lo[ks]) : "v"(vb), "i"(d0 * 4096 + ks * 1024) : "memory");
            asm volatile("ds_read_b64_tr_b16 %0,%1 offset:%c2" : "=&v"(hi[ks]) : "v"(vb), "i"(d0 * 4096 + ks * 1024 + 512) : "memory"); }
        asm volatile("s_waitcnt lgkmcnt(0)" ::: "memory"); __builtin_amdgcn_sched_barrier(0);
#define AT_PK(k) (bf16x8){lo[k][0], lo[k][1], lo[k][2], lo[k][3], hi[k][0], hi[k][1], hi[k][2], hi[k][3]}
        o[d0] = __builtin_amdgcn_mfma_f32_32x32x16_bf16(pa0, AT_PK(0), o[d0], 0, 0, 0);
        o[d0] = __builtin_amdgcn_mfma_f32_32x32x16_bf16(pa1, AT_PK(1), o[d0], 0, 0, 0);
        o[d0] = __builtin_amdgcn_mfma_f32_32x32x16_bf16(pa2, AT_PK(2), o[d0], 0, 0, 0);
        o[d0] = __builtin_amdgcn_mfma_f32_32x32x16_bf16(pa3, AT_PK(3), o[d0], 0, 0, 0);
#undef AT_PK
    }
}
__device__ __forceinline__ float maskv(float v, unsigned wsh, int pos) { const int keep = ((int)(wsh << (31 - pos))) >> 31; return __uint_as_float((__float_as_uint(v) & (unsigned)keep) | (0xFF800000u & ~(unsigned)keep)); }

__device__ __forceinline__ void attn_unit(Frame& F, int bl, int n, int c) {
    using namespace fx;
    int lane_l = F.lane; asm volatile("" : "+v"(lane_l));
    const int lane = lane_l, r32 = lane & 31, hi = lane >> 5, wid = F.wave, tid = wid * 64 + lane;
    const int hh = 4 * n + (wid >> 1), qoff = (wid & 1) * 32;
    const long rowbase = (long)bl * T; const int q0 = c * 64, NT = c + 1;
    const bf16* Qw = (const bf16*)(F.ws + WS_QA) + (size_t)(rowbase + q0 + qoff) * 512 + hh * 64;
    const bf16* Kh = (const bf16*)(F.ws + WS_KA) + (size_t)rowbase * 128 + n * 64;
    const bf16* Vh = (const bf16*)(F.ws + WS_VA) + (size_t)rowbase * 128 + n * 64;
    const unsigned* SELM = selm_ptr(F.ws) + (size_t)(rowbase + q0) * 64;
    const unsigned lds0 = (unsigned)(uintptr_t)F.lds;
    LAS float* wsf = (LAS float*)(F.lds + LDS_WS) + wid * 64;
    LAS unsigned* MK = (LAS unsigned*)(F.lds + LDS_MK);
    const bf16* ksrc = Kh + (size_t)lane * 128 + wid * 8;
    const bf16* vsrc = Vh + (size_t)(16 * (wid & 3) + (lane >> 2)) * 128 + (wid >> 2) * 32 + (lane & 3) * 8;
    const unsigned kdst = lds0 + LDS_K + wid * 1024, vdst = lds0 + LDS_V + wid * 1024;
#define AT_DMA_K(t, slot) glds16(ksrc + (size_t)(t) * 64 * 128, (unsigned)__builtin_amdgcn_readfirstlane(kdst + (slot) * SLOTB))
#define AT_DMA_V(t, slot) glds16(vsrc + (size_t)(t) * 64 * 128, (unsigned)__builtin_amdgcn_readfirstlane(vdst + (slot) * SLOTB))
    const int vb0 = (int)(lds0 + LDS_V) + ((lane >> 4) & 1) * 32 + (lane & 3) * 8 + (4 * hi + ((lane & 15) >> 2)) * 64;
    AT_DMA_K(0, 0); AT_DMA_V(0, 0);
    bf16x8 qr[4];
#pragma unroll
    for (int d0 = 0; d0 < 4; ++d0) qr[d0] = *(const bf16x8*)&Qw[(size_t)r32 * 512 + d0 * 16 + hi * 8];
    for (int i = tid; i < 64 * 64; i += 512) MK[(i >> 6) * MKS + (i & 63)] = SELM[i];
    float m = -1e30f, l = 0.f; f32x16 o[2]; o[0] = f32x16{}; o[1] = f32x16{};
#pragma unroll 1
    for (int t = 0; t < NT; ++t) {
        asm volatile("s_waitcnt vmcnt(0)" ::: "memory"); __syncthreads();
        const int sl = t & 1;
        if (t + 1 < NT) { AT_DMA_K(t + 1, sl ^ 1); AT_DMA_V(t + 1, sl ^ 1); }
        f32x16 p0, p1;
        qkt(p0, p1, (const LAS char*)(F.lds + LDS_K + sl * SLOTB), qr, r32, hi);
        { const u32x2 mw = *(const LAS u32x2*)(MK + (qoff + r32) * MKS + 2 * t); const unsigned w0 = mw.x >> (4 * hi), w1 = mw.y >> (4 * hi);
#pragma unroll
          for (int r = 0; r < 16; ++r) { const int pos = (r & 3) + 8 * (r >> 2); p0[r] = maskv(p0[r], w0, pos); p1[r] = maskv(p1[r], w1, pos); } }
        const float rm = rowmax(p0, p1), mn = fmaxf(m, rm), alpha = __builtin_amdgcn_exp2f(m - mn); m = mn;
        float s = 0.f;
#pragma unroll
        for (int r = 0; r < 16; ++r) { p0[r] = __builtin_amdgcn_exp2f(p0[r] - m); p1[r] = __builtin_amdgcn_exp2f(p1[r] - m); s += p0[r] + p1[r]; }
        l = l * alpha + s;
        if (!__all(alpha == 1.0f)) {
            if (hi == 0) wsf[r32] = alpha;
            asm volatile("s_waitcnt lgkmcnt(0)" ::: "memory");
#pragma unroll
            for (int r = 0; r < 16; ++r) { const float f = wsf[crow(r, hi)]; o[0][r] *= f; o[1][r] *= f; }
        }
        u32x4 pw0, pw1, pw2, pw3;
        pw0 = (u32x4){cvtpk_s(p0[0], p0[1]), cvtpk_s(p0[2], p0[3]), cvtpk_s(p0[4], p0[5]), cvtpk_s(p0[6], p0[7])};
        pw1 = (u32x4){cvtpk_s(p0[8], p0[9]), cvtpk_s(p0[10], p0[11]), cvtpk_s(p0[12], p0[13]), cvtpk_s(p0[14], p0[15])};
        pw2 = (u32x4){cvtpk_s(p1[0], p1[1]), cvtpk_s(p1[2], p1[3]), cvtpk_s(p1[4], p1[5]), cvtpk_s(p1[6], p1[7])};
        pw3 = (u32x4){cvtpk_s(p1[8], p1[9]), cvtpk_s(p1[10], p1[11]), cvtpk_s(p1[12], p1[13]), cvtpk_s(p1[14], p1[15])};
        pv(o, vb0 + sl * SLOTB, __builtin_bit_cast(bf16x8, pw0), __builtin_bit_cast(bf16x8, pw1), __builtin_bit_cast(bf16x8, pw2), __builtin_bit_cast(bf16x8, pw3));
    }
    { auto rr = __builtin_amdgcn_permlane32_swap(__float_as_uint(l), __float_as_uint(l), false, false); l = __uint_as_float(rr[0]) + __uint_as_float(rr[1]); }
    if (hi == 0) wsf[32 + r32] = l;
    asm volatile("s_waitcnt lgkmcnt(0)" ::: "memory");
    bf16* Ow = (bf16*)(F.ws + WS_MIX) + (size_t)(rowbase + q0 + qoff) * 1024 + hh * 64;
    { LAS bf16* stg = (LAS bf16*)(F.lds + LDS_OST) + wid * 2048;
#pragma unroll
      for (int r = 0; r < 16; ++r) { const int orow = crow(r, hi); const float rl = __builtin_amdgcn_rcpf(wsf[32 + orow]);
#pragma unroll
          for (int d0 = 0; d0 < 2; ++d0) stg[orow * 64 + d0 * 32 + r32] = (bf16)f2bf(o[d0][r] * rl); }
      asm volatile("s_waitcnt lgkmcnt(0)" ::: "memory");
#pragma unroll
      for (int i = 0; i < 4; ++i) { const int row = i * 8 + (lane >> 3), ch = lane & 7; const u32x4 v = *(const LAS u32x4*)(stg + row * 64 + ch * 8); *(u32x4*)(Ow + (size_t)row * 1024 + ch * 8) = v; } }
    __syncthreads();
#undef AT_DMA_K
#undef AT_DMA_V
}
static_assert(LDS_END <= 163328, "attention LDS map");
}
__device__ __forceinline__ void attn_phase(Frame& F) {
    using namespace fx;
    const int npair = NBUF * 2 * 16;
    for (int j = F.vcu; j < npair; j += F.G) {
        const int bl = j / 32, rem = j % 32, n = rem / 16, s = rem % 16;
        at::attn_unit(F, bl, n, 31 - s);
        at::attn_unit(F, bl, n, s);
    }
}
namespace dn {
using namespace fx;
constexpr int NTASK = NBUF * 4 * 32;
constexpr size_t REC_W = 0, REC_QD = 16384, REC_KT = 32768, REC_ATT = 49152, REC_BYTES = 57344;
constexpr size_t WS_REC = (NBUF == 8) ? 199 * MiB : 240 * MiB;
constexpr size_t WS_U = WS_XB;
constexpr size_t WS_GL = WS_GC;
static_assert(WS_REC + (size_t)NTASK * REC_BYTES <= 255 * MiB, "REC region");
static_assert((size_t)NTASK * 16384 <= RB * 1024 * 2, "U fits in XB");
constexpr int L_QN = 0, L_KN = 16384, L_VT = 32768, L_KBT = 49152, L_KTT = 65536, L_M = 81920, L_TINV = 98304, L_GC = 106496  , L_BETA = L_GC + 320  , L_END = L_BETA + 256;
__device__ __forceinline__ int sw256(int row, int unit) { return unit ^ (row & 15); }
__device__ __forceinline__ int sw128(int row, int unit) { return unit ^ ((row >> 1) & 7); }
__device__ __forceinline__ unsigned pkbf(float a, float b) { return at::cvtpk_s(a, b); }
typedef unsigned u32x2_t __attribute__((ext_vector_type(2)));
typedef unsigned u32x4_t __attribute__((ext_vector_type(4)));
typedef float f4 __attribute__((ext_vector_type(4)));
using bf16x8 = __attribute__((ext_vector_type(8))) short;

__device__ __forceinline__ void prep_unit(Frame& F, int bl, int h, int c) {
    int lane_l = F.lane; asm volatile("" : "+v"(lane_l));
    const int lane = lane_l, w = F.wave, tid = w * 64 + lane, r16 = lane & 15, g = lane >> 4;
    const int task = (bl * 4 + h) * 32 + c; const size_t row0 = (size_t)bl * T + c * 64;
    LAS unsigned char* L = F.lds;
    LAS float* GCs = (LAS float*)(L + L_GC); LAS float* BET = (LAS float*)(L + L_BETA); LAS float* Mf = (LAS float*)(L + L_M);
    if (w == 0) {
        float gv = ((const float*)(F.ws + WS_GG))[(row0 + lane) * 4 + h];
#pragma unroll
        for (int o = 1; o < 64; o <<= 1) { const float t = __shfl_up(gv, o); if (lane >= o) gv += t; }
        GCs[lane] = gv; if (lane == 63) { GCs[64] = gv; ((float*)(F.ws + WS_GL))[task] = __expf(gv); }
        BET[lane] = ((const float*)(F.ws + WS_BETA))[(row0 + lane) * 4 + h];
    }
    __syncthreads();
    {
        const int i = tid >> 3, p = tid & 7, d0 = 16 * p; const float gci = GCs[i], gcl = GCs[64], bet = BET[i];
        const float ekb = bet * __expf(gci), ekt = __expf(gcl - gci);
#pragma unroll 1
        for (int which = 0; which < 3; ++which) {
            const bf16* src = (const bf16*)(F.ws + WS_QB4) + (size_t)which * RB * 512 + h * 128 + d0;
            const float* cw = F.conv_w + which * 512 + h * 128 + d0;
            float a[16];
#pragma unroll
            for (int d = 0; d < 16; ++d) a[d] = 0.f;
#pragma unroll
            for (int j = 0; j < 4; ++j) {
                const int tl = c * 64 + i - 3 + j;
                if (tl >= 0) {
                    const bf16* rp = src + ((size_t)bl * T + tl) * 512; const u32x4_t x0 = *(const u32x4_t*)rp, x1 = *(const u32x4_t*)(rp + 8);
                    const f4 w0 = *(const f4*)(cw + j * 1536), w1 = *(const f4*)(cw + j * 1536 + 4), w2 = *(const f4*)(cw + j * 1536 + 8), w3 = *(const f4*)(cw + j * 1536 + 12);
                    const float wv[16] = {w0[0], w0[1], w0[2], w0[3], w1[0], w1[1], w1[2], w1[3], w2[0], w2[1], w2[2], w2[3], w3[0], w3[1], w3[2], w3[3]};
                    const unsigned xs[8] = {x0[0], x0[1], x0[2], x0[3], x1[0], x1[1], x1[2], x1[3]};
#pragma unroll
                    for (int q = 0; q < 8; ++q) { a[2 * q] += wv[2 * q] * __uint_as_float(xs[q] << 16); a[2 * q + 1] += wv[2 * q + 1] * __uint_as_float(xs[q] & 0xffff0000u); }
                }
                asm volatile("" ::: "memory");
            }
            float ss = 0.f;
#pragma unroll
            for (int d = 0; d < 16; ++d) { a[d] = a[d] / (1.0f + __expf(-a[d])); ss += a[d] * a[d]; }
            if (which < 2) {
                ss += __shfl_xor(ss, 1); ss += __shfl_xor(ss, 2); ss += __shfl_xor(ss, 4);
                const float inv = 1.0f / sqrtf(ss + EPS);
#pragma unroll
                for (int d = 0; d < 16; ++d) a[d] *= inv;
                LAS unsigned char* dst = L + (which == 0 ? L_QN : L_KN) + i * 256;
                *(LAS u32x4_t*)(dst + sw256(i, 2 * p) * 16) = (u32x4_t){pkbf(a[0], a[1]), pkbf(a[2], a[3]), pkbf(a[4], a[5]), pkbf(a[6], a[7])};
                *(LAS u32x4_t*)(dst + sw256(i, 2 * p + 1) * 16) = (u32x4_t){pkbf(a[8], a[9]), pkbf(a[10], a[11]), pkbf(a[12], a[13]), pkbf(a[14], a[15])};
            }
            if (which >= 1) {
#pragma unroll
                for (int d = 0; d < 16; ++d) { const int dd = d0 + d; const int off = dd * 128 + sw128(dd, i >> 3) * 16 + (i & 7) * 2;
                    if (which == 1) { *(LAS bf16*)(L + L_KBT + off) = (bf16)f2bf(a[d] * ekb); *(LAS bf16*)(L + L_KTT + off) = (bf16)f2bf(a[d] * ekt); }
                    else *(LAS bf16*)(L + L_VT + off) = (bf16)f2bf(a[d] * bet); }
            }
        }
    }
    __syncthreads();
    {
        const int it = w >> 1, kkA = w & 1;
        f4 dm[2], da[2];
#pragma unroll
        for (int u = 0; u < 2; ++u) {
            const int jt = 2 * kkA + u; f4 accm = {0.f, 0.f, 0.f, 0.f}, acca = accm;
#pragma unroll
            for (int kk = 0; kk < 4; ++kk) {
                const int ri = 16 * it + r16, rj = 16 * jt + r16;
                const bf16x8 ki = *(const LAS bf16x8*)(L + L_KN + ri * 256 + sw256(ri, 4 * kk + g) * 16);
                const bf16x8 kj = *(const LAS bf16x8*)(L + L_KN + rj * 256 + sw256(rj, 4 * kk + g) * 16);
                const bf16x8 qi = *(const LAS bf16x8*)(L + L_QN + ri * 256 + sw256(ri, 4 * kk + g) * 16);
                accm = __builtin_amdgcn_mfma_f32_16x16x32_bf16(ki, kj, accm, 0, 0, 0);
                acca = __builtin_amdgcn_mfma_f32_16x16x32_bf16(kj, qi, acca, 0, 0, 0);
            }
            dm[u] = accm; da[u] = acca;
        }
#pragma unroll
        for (int u = 0; u < 2; ++u) {
            const int jt = 2 * kkA + u;
            { const int j = 16 * jt + r16; const float gj = GCs[j];
#pragma unroll
              for (int r = 0; r < 4; ++r) { const int i = 16 * it + 4 * g + r; Mf[i * 64 + j] = (j < i) ? BET[i] * dm[u][r] * __expf(GCs[i] - gj) : 0.f; } }
            { const int i = 16 * it + r16; const float gi = GCs[i];
#pragma unroll
              for (int r = 0; r < 4; ++r) { const int j = 16 * jt + 4 * g + r; da[u][r] = (j <= i) ? da[u][r] * 0.08838834764831845f * __expf(gi - GCs[j]) : 0.f; } }
        }
        const u32x4_t av = {pkbf(da[0][0], da[0][1]), pkbf(da[0][2], da[0][3]), pkbf(da[1][0], da[1][1]), pkbf(da[1][2], da[1][3])};
        *(u32x4_t*)(F.ws + WS_REC + (size_t)task * REC_BYTES + REC_ATT + (size_t)(it * 2 + kkA) * 1024 + lane * 16) = av;
    }
    __syncthreads();
    if (w == 0) {
        float Tm[64];
        const LAS float* Mv = Mf; asm volatile("" : "+v"(Mv));
#pragma unroll
        for (int i = 0; i < 64; ++i) {
            float acc = (lane == i) ? 1.f : 0.f;
#pragma unroll
            for (int j4 = 0; j4 < (i + 3) / 4; ++j4) { const f4 mv = *(const LAS f4*)(Mv + i * 64 + 4 * j4);
#pragma unroll
                for (int jj = 0; jj < 4; ++jj) if (4 * j4 + jj < i) acc -= mv[jj] * Tm[4 * j4 + jj]; }
            Tm[i] = acc;
            *(LAS bf16*)(L + L_TINV + i * 128 + sw128(i, lane >> 3) * 16 + (lane & 7) * 2) = (bf16)f2bf(acc);
            asm volatile("" ::: "memory");
        }
    } else {
        for (int f = w - 1; f < 32; f += 7) {
            if (f < 16) {
                const int m = f >> 2, kk = f & 3, i = 16 * m + r16; const float sc = 0.08838834764831845f * __expf(GCs[i]);
                const u32x2_t a = *(const LAS u32x2_t*)(L + L_QN + i * 256 + sw256(i, 4 * kk + (g >> 1)) * 16 + (g & 1) * 8), b = *(const LAS u32x2_t*)(L + L_QN + i * 256 + sw256(i, 4 * kk + 2 + (g >> 1)) * 16 + (g & 1) * 8);
                const unsigned xs[4] = {a[0], a[1], b[0], b[1]}; u32x4_t o;
#pragma unroll
                for (int q = 0; q < 4; ++q) o[q] = pkbf(__uint_as_float(xs[q] << 16) * sc, __uint_as_float(xs[q] & 0xffff0000u) * sc);
                *(u32x4_t*)(F.ws + WS_REC + (size_t)task * REC_BYTES + REC_QD + (size_t)(m * 4 + kk) * 1024 + lane * 16) = o;
            } else {
                const int f2 = f - 16, m = f2 >> 1, kk = f2 & 1, d = 16 * m + r16;
                const u32x2_t a = *(const LAS u32x2_t*)(L + L_KTT + d * 128 + sw128(d, 4 * kk + (g >> 1)) * 16 + (g & 1) * 8), b = *(const LAS u32x2_t*)(L + L_KTT + d * 128 + sw128(d, 4 * kk + 2 + (g >> 1)) * 16 + (g & 1) * 8);
                *(u32x4_t*)(F.ws + WS_REC + (size_t)task * REC_BYTES + REC_KT + (size_t)(m * 2 + kk) * 1024 + lane * 16) = (u32x4_t){a[0], a[1], b[0], b[1]};
            }
        }
    }
    __syncthreads();
    {
        unsigned long long* Uimg = (unsigned long long*)(F.ws + WS_U + (size_t)task * 16384);
#pragma unroll
        for (int it = 0; it < 4; ++it) {
            f4 acc = {0.f, 0.f, 0.f, 0.f};
#pragma unroll
            for (int kk = 0; kk < 2; ++kk) {
                const int ri = 16 * it + r16, re = 16 * w + r16;
                const bf16x8 ta = *(const LAS bf16x8*)(L + L_TINV + ri * 128 + sw128(ri, 4 * kk + g) * 16);
                const bf16x8 vb = *(const LAS bf16x8*)(L + L_VT + re * 128 + sw128(re, 4 * kk + g) * 16);
                acc = __builtin_amdgcn_mfma_f32_16x16x32_bf16(ta, vb, acc, 0, 0, 0);
            }
            Uimg[(size_t)(w * 4 + it) * 64 + lane] = (unsigned long long)pkbf(acc[0], acc[1]) | ((unsigned long long)pkbf(acc[2], acc[3]) << 32);
        }
        const int kkW = w >> 1;
#pragma unroll
        for (int ii = 0; ii < 2; ++ii) {
            const int it = 2 * (w & 1) + ii; f4 acc[2];
#pragma unroll
            for (int u = 0; u < 2; ++u) {
                const int dt = 2 * kkW + u; acc[u] = (f4){0.f, 0.f, 0.f, 0.f};
#pragma unroll
                for (int kk = 0; kk < 2; ++kk) {
                    const int rd = 16 * dt + r16, ri = 16 * it + r16;
                    const bf16x8 ka = *(const LAS bf16x8*)(L + L_KBT + rd * 128 + sw128(rd, 4 * kk + g) * 16);
                    const bf16x8 tb = *(const LAS bf16x8*)(L + L_TINV + ri * 128 + sw128(ri, 4 * kk + g) * 16);
                    acc[u] = __builtin_amdgcn_mfma_f32_16x16x32_bf16(ka, tb, acc[u], 0, 0, 0);
                }
            }
            *(u32x4_t*)(F.ws + WS_REC + (size_t)task * REC_BYTES + REC_W + (size_t)(it * 4 + kkW) * 1024 + lane * 16) = (u32x4_t){pkbf(acc[0][0], acc[0][1]), pkbf(acc[0][2], acc[0][3]), pkbf(acc[1][0], acc[1][1]), pkbf(acc[1][2], acc[1][3])};
        }
    }
    __syncthreads();
}
static_assert(L_END <= 163328, "prep LDS map");
}
__device__ __forceinline__ void prep_phase(Frame& F) {
    for (int t = F.vcu; t < dn::NTASK; t += F.G) { const int c = t & 31, h = (t >> 5) & 3, bl = t >> 7; dn::prep_unit(F, bl, h, c); }
}
#ifdef HYBRID
__device__ __forceinline__ void convert_c1(Frame& F, const nv::NP& p, long tid, long nth) {
    using namespace dn;
    const float* GCsrc = nullptr; (void)GCsrc;
    for (long i = tid; i < (long)32 * 4 * 64 * 128; i += nth) {
        const int x = (int)(i & 127), ii = (int)((i >> 7) & 63), h = (int)((i >> 13) & 3), c = (int)(i >> 15); const int task = h * 32 + c;
        const int t = c * 64 + ii;
        { const bf16* U = (const bf16*)(F.ws + WS_U + (size_t)task * 16384); const int ln = (x & 15) + 16 * ((ii & 15) >> 2);
          p.sol[((size_t)(c * 4 + h) * 64 + ii) * 256 + x] = bf2f(U[((size_t)((x >> 4) * 4 + (ii >> 4)) * 64 + ln) * 4 + (ii & 3)]); }
        { const int m = ii >> 4, kk = x >> 5, xx = x & 31, half = xx >> 4, g = (xx & 15) >> 2, j = (xx & 3) + 4 * half, ln = (ii & 15) + 16 * g;
          const bf16* W = (const bf16*)(F.ws + WS_REC + (size_t)task * REC_BYTES + REC_W); const bf16* Q = (const bf16*)(F.ws + WS_REC + (size_t)task * REC_BYTES + REC_QD);
          p.sol[((size_t)(c * 4 + h) * 64 + ii) * 256 + 128 + x] = bf2f(W[((size_t)(m * 4 + kk) * 64 + ln) * 8 + j]);
          const float gci = p.bg[((size_t)t * 4 + h) * 3 + 2];
          p.qkvc[(size_t)t * 1536 + h * 128 + x] = bf2f(Q[((size_t)(m * 4 + kk) * 64 + ln) * 8 + j]) / (0.08838834764831845f * expf(gci)); }
        { const int m = x >> 4, kk = ii >> 5, xx = ii & 31, half = xx >> 4, g = (xx & 15) >> 2, j = (xx & 3) + 4 * half, ln = (x & 15) + 16 * g;
          const bf16* K = (const bf16*)(F.ws + WS_REC + (size_t)task * REC_BYTES + REC_KT);
          const float gci = p.bg[((size_t)t * 4 + h) * 3 + 2], gcl = p.bg[((size_t)(c * 64 + 63) * 4 + h) * 3 + 2];
          p.qkvc[(size_t)t * 1536 + 512 + h * 128 + x] = bf2f(K[((size_t)(m * 2 + kk) * 64 + ln) * 8 + j]) / expf(gcl - gci); }
        if (x < 64) { const int m = ii >> 4, kk = x >> 5, xx = x & 31, half = xx >> 4, g = (xx & 15) >> 2, j = (xx & 3) + 4 * half, ln = (ii & 15) + 16 * g;
          const bf16* A = (const bf16*)(F.ws + WS_REC + (size_t)task * REC_BYTES + REC_ATT);
          p.att[((size_t)(c * 4 + h) * 64 + ii) * 64 + x] = bf2f(A[((size_t)(m * 2 + kk) * 64 + ln) * 8 + j]); }
    }
}
#endif
namespace dn {
__device__ __forceinline__ void scan_unit(Frame& F, int bl, int h) {
    int lane_l = F.lane; asm volatile("" : "+v"(lane_l));
    const int lane = lane_l, wv = F.wave;
    const int task0 = (bl * 4 + h) * 32;
    LAS unsigned char* L = F.lds; const unsigned lds0 = (unsigned)(uintptr_t)F.lds;
    const unsigned char* rec = F.ws + WS_REC + (size_t)task0 * REC_BYTES + lane * 16;
    unsigned long long* Uimg = (unsigned long long*)(F.ws + WS_U) + ((size_t)task0 * 8 + wv) * 4 * 64 + lane;
    const float* GLp = (const float*)(F.ws + WS_GL) + task0;
#define DN_GLDS(c, buf) do { _Pragma("unroll") for (int p_ = 0; p_ < 7; ++p_) at::glds16(rec + (size_t)(c) * REC_BYTES + (size_t)(wv + 8 * p_) * 1024, (unsigned)__builtin_amdgcn_readfirstlane(lds0 + (buf) * 57344 + (wv + 8 * p_) * 1024)); } while (0)
    f4 S[8];
#pragma unroll
    for (int d = 0; d < 8; ++d) S[d] = (f4){0.f, 0.f, 0.f, 0.f};
    unsigned long long un[4]; float gln;
#pragma unroll
    for (int m = 0; m < 4; ++m) un[m] = Uimg[m * 64];
    gln = GLp[0];
    DN_GLDS(0, 0);
#pragma unroll 1
    for (int c = 0; c < 32; ++c) {
        asm volatile("s_waitcnt vmcnt(0)" ::: "memory"); __syncthreads();
        unsigned long long uc[4]; float gl = gln;
#pragma unroll
        for (int m = 0; m < 4; ++m) uc[m] = un[m];
        if (c + 1 < 32) {
#pragma unroll
            for (int m = 0; m < 4; ++m) un[m] = Uimg[(size_t)(c + 1) * 2048 + m * 64];
            gln = GLp[c + 1];
            DN_GLDS(c + 1, (c + 1) & 1);
        }
        const LAS unsigned char* B = L + (c & 1) * 57344 + lane * 16;
        bf16x8 sb[4];
#pragma unroll
        for (int kk = 0; kk < 4; ++kk) { const u32x4_t v = {pkbf(S[2 * kk][0], S[2 * kk][1]), pkbf(S[2 * kk][2], S[2 * kk][3]), pkbf(S[2 * kk + 1][0], S[2 * kk + 1][1]), pkbf(S[2 * kk + 1][2], S[2 * kk + 1][3])}; sb[kk] = __builtin_bit_cast(bf16x8, v); }
        f4 vn[4], O[4];
#pragma unroll
        for (int m = 0; m < 4; ++m) {
            f4 t1 = {0.f, 0.f, 0.f, 0.f}, oq = t1;
#pragma unroll
            for (int kk = 0; kk < 4; ++kk) {
                t1 = __builtin_amdgcn_mfma_f32_16x16x32_bf16(*(const LAS bf16x8*)(B + REC_W + (m * 4 + kk) * 1024), sb[kk], t1, 0, 0, 0);
                oq = __builtin_amdgcn_mfma_f32_16x16x32_bf16(*(const LAS bf16x8*)(B + REC_QD + (m * 4 + kk) * 1024), sb[kk], oq, 0, 0, 0);
            }
            const unsigned ulo = (unsigned)uc[m], uhi = (unsigned)(uc[m] >> 32);
            vn[m] = (f4){__uint_as_float(ulo << 16) - t1[0], __uint_as_float(ulo & 0xffff0000u) - t1[1], __uint_as_float(uhi << 16) - t1[2], __uint_as_float(uhi & 0xffff0000u) - t1[3]};
            O[m] = oq;
        }
        bf16x8 vb[2];
#pragma unroll
        for (int k2 = 0; k2 < 2; ++k2) { const u32x4_t v = {pkbf(vn[2 * k2][0], vn[2 * k2][1]), pkbf(vn[2 * k2][2], vn[2 * k2][3]), pkbf(vn[2 * k2 + 1][0], vn[2 * k2 + 1][1]), pkbf(vn[2 * k2 + 1][2], vn[2 * k2 + 1][3])}; vb[k2] = __builtin_bit_cast(bf16x8, v); }
#pragma unroll
        for (int m = 0; m < 4; ++m) {
#pragma unroll
            for (int k2 = 0; k2 < 2; ++k2) O[m] = __builtin_amdgcn_mfma_f32_16x16x32_bf16(*(const LAS bf16x8*)(B + REC_ATT + (m * 2 + k2) * 1024), vb[k2], O[m], 0, 0, 0);
            Uimg[(size_t)c * 2048 + m * 64] = (unsigned long long)pkbf(O[m][0], O[m][1]) | ((unsigned long long)pkbf(O[m][2], O[m][3]) << 32);
        }
#pragma unroll
        for (int d = 0; d < 8; ++d) {
            f4 s = S[d] * gl;
#pragma unroll
            for (int k2 = 0; k2 < 2; ++k2) s = __builtin_amdgcn_mfma_f32_16x16x32_bf16(*(const LAS bf16x8*)(B + REC_KT + (d * 2 + k2) * 1024), vb[k2], s, 0, 0, 0);
            S[d] = s;
        }
    }
    asm volatile("s_waitcnt vmcnt(0)" ::: "memory"); __syncthreads();
#undef DN_GLDS
}
}
__device__ __forceinline__ void scan_phase(Frame& F) {
    for (int u = blockIdx.x; u < NBUF * 4; u += F.G) dn::scan_unit(F, u >> 2, u & 3);
}
__device__ __forceinline__ void gnorm_phase(Frame& F) {
    using namespace fx;
    const int gw = F.vcu * NWAVES + F.wave, NGW = F.G * NWAVES; const int lane = F.lane;
    const bf16* OB = (const bf16*)(F.ws + dn::WS_U); const bf16* ZB = (const bf16*)(F.ws + WS_QB4) + (size_t)3 * RB * 512; bf16* MIX = (bf16*)(F.ws + WS_MIX);
    const int e0 = 2 * lane, wv = e0 >> 4, e15 = e0 & 15;
    const float g0 = F.gdn_g[e0], g1 = F.gdn_g[e0 + 1];
    for (int it = gw; it < MB * 4; it += NGW) {
        const int row = it >> 2, h = it & 3, bl = row / T, t = row % T, c = t >> 6, i = t & 63, m = i >> 4, g = (i & 15) >> 2, r = i & 3;
        const size_t task = (size_t)(bl * 4 + h) * 32 + c;
        const size_t base = (((task * 8 + wv) * 4 + m) * 64 + (g * 16 + e15)) * 4 + r;
        const float o0 = bf2f(OB[base]), o1 = bf2f(OB[base + 4]);
        const float ss = wave_sum(o0 * o0 + o1 * o1);
        const float rr = 1.0f / sqrtf(ss * (1.0f / 128.0f) + EPS);
        const unsigned zz = *(const unsigned*)(ZB + (size_t)row * 512 + h * 128 + e0);
        const float z0 = __uint_as_float(zz << 16), z1 = __uint_as_float(zz & 0xffff0000u);
        const float y0 = o0 * rr * g0 * (z0 / (1.0f + __expf(-z0))), y1 = o1 * rr * g1 * (z1 / (1.0f + __expf(-z1)));
        *(unsigned*)(MIX + (size_t)row * 1024 + 512 + h * 128 + e0) = at::cvtpk_s(y0, y1);
    }
}
struct Args { const float* in[12]; float* out; unsigned char* ws; };
__global__ void __launch_bounds__(512, 2) fwd(Args args) {
    extern __shared__ __attribute__((aligned(16))) unsigned char lds[];
    Frame F;
    F.lds = (LAS unsigned char*)lds; F.MISC = (volatile LAS unsigned*)(F.lds + MISC_OFF);
    F.tid = threadIdx.x; F.lane = F.tid & 63; F.wave = __builtin_amdgcn_readfirstlane(F.tid >> 6);
    F.G = gridDim.x; { const int bx = blockIdx.x; F.vcu = (F.G % 8 == 0) ? (bx % 8) * (F.G / 8) + bx / 8 : bx; }
    F.ws = args.ws; F.ctl = (gu32*)(args.ws + fx::WS_CTL);
    F.x = args.in[0]; F.g1 = args.in[1]; F.w_in = args.in[2]; F.conv_w = args.in[3]; F.a_log = args.in[4]; F.dt_bias = args.in[5]; F.gdn_g = args.in[6]; F.w_out = args.in[7];
    F.g2 = args.in[8]; F.w1 = args.in[9]; F.w2 = args.in[10]; F.gf = args.in[11]; F.out = args.out;
    for (int u = F.tid; u < (LDS_BYTES - LDSCTL_OFF) / 4; u += 512) ((LAS unsigned*)(F.lds + LDSCTL_OFF))[u] = 0u;
    __syncthreads();
    XcdBarrier bar = xcd_barrier_post((unsigned*)(F.ctl + CW_BAR), F.MISC + 8);
#define GRID_BAR() xcd_barrier(bar)
    p0_weights(F); p0_rows(F, 0);
    GRID_BAR();
    { pg8::Gemm g{(const pg8::bf16_t*)(F.ws + fx::WS_XB), (const pg8::bf16_t*)(F.ws + fx::WS_WIN), fx::MB, fx::NPROJ, fx::D}; pg8::StaticOrder S; S.init(fx::MB, fx::NPROJ, F.G, (int)blockIdx.x);
      pg8::EpiProj E{F.ws, F.a_log, F.dt_bias};
      pg8::gemm_phase<pg8::EpiProj, pg8::StaticOrder, true, true>(F.lds + RING_OFF, g, S, E); }
    GRID_BAR();
    idx_phase(F); prep_phase(F);
    GRID_BAR();
    attn_phase(F); scan_phase(F);
    GRID_BAR();
    gnorm_phase(F);
    GRID_BAR();
    phases_d(F, bar, 0);
}
extern "C" void kernel_launch(void* const* d_in, const int* in_sizes, int n_in, void* d_out, int out_size, void* d_ws, size_t ws_size, hipStream_t stream) {
    static int grid = 0;
    if (grid == 0) {
        int dev = 0, cus = 0;
        if (n_in != 12 || out_size != fx::NB * fx::T * fx::D || ws_size < (size_t)256 * fx::MiB) { fprintf(stderr, "kernel_launch: unexpected shapes (n_in %d, out %d, ws %zu)\n", n_in, out_size, ws_size); grid = -1; return; }
        if (hipGetDevice(&dev) != hipSuccess || hipDeviceGetAttribute(&cus, hipDeviceAttributeMultiprocessorCount, dev) != hipSuccess) { fprintf(stderr, "kernel_launch: device query failed\n"); grid = -1; return; }
        if (hipFuncSetAttribute((const void*)fwd, hipFuncAttributeMaxDynamicSharedMemorySize, LDS_BYTES) != hipSuccess) { fprintf(stderr, "kernel_launch: hipFuncSetAttribute failed\n"); grid = -1; return; }
        grid = cus;
    }
    if (grid < 0) return;
    hipMemsetAsync((char*)d_ws + fx::WS_CTL, 0, 65536, stream);
    Args a{};
    for (int i = 0; i < 12; ++i) a.in[i] = (const float*)d_in[i];
    a.out = (float*)d_out; a.ws = (unsigned char*)d_ws;
    hipLaunchKernelGGL(fwd, dim3(grid), dim3(512), LDS_BYTES, stream, a);
}
```
